# Optimizing an MI355X kernel written in HIP

```python
import math
import jax, jax.numpy as jnp
from jax import lax
import numpy as np

D_MODEL = 2048
BATCH = 1
SEQ = 8192
DEPTH = 2
DEC_BATCH = 128
DEC_SEQ = 4
PAST_LEN = 8192
PAGE_SIZE = 128

N_EVEN = (DEPTH + 1) // 2
N_ODD = DEPTH // 2
HEAD_DIM = 64
ROT_DIM = HEAD_DIM // 4
ROPE_THETA = 500000.0
NORM_EPS = 1e-5
BAND = 128

SSD_HEADDIM = 64
SSD_INNER = D_MODEL
SSD_HEADS = SSD_INNER // SSD_HEADDIM
SSD_GROUPS = 4
SSD_STATE = 128
SSD_CONV = 4
SSD_CHUNK = 128
CONV_DIM = SSD_INNER + 2 * SSD_GROUPS * SSD_STATE

SWA_WINDOW = 128
SWA_HEADS = D_MODEL // HEAD_DIM
SWA_KV = 8
SWA_REP = SWA_HEADS // SWA_KV

DIL_PATTERNS = ((128, 1), (512, 4), (2048, 16))
N_DIL = len(DIL_PATTERNS)
DIL_HEADS = D_MODEL // HEAD_DIM
DIL_KV = 8
DIL_REP = DIL_HEADS // DIL_KV
DIL_MAX_WINDOW = max(w for w, _ in DIL_PATTERNS)

MLP_HIDDEN = 4 * D_MODEL

E_SIZES = (SSD_INNER, CONV_DIM, SSD_HEADS, SWA_HEADS * HEAD_DIM, SWA_KV * HEAD_DIM, SWA_KV * HEAD_DIM)
E_IN = sum(E_SIZES)
E_OUT = SSD_INNER + SWA_HEADS * HEAD_DIM
O_SIZES = (N_DIL * DIL_HEADS * HEAD_DIM, DIL_KV * HEAD_DIM, DIL_KV * HEAD_DIM)
O_IN = sum(O_SIZES)
O_OUT = DIL_HEADS * HEAD_DIM

kernel_name = 'hybrid_ssd_swa_dilated_decoder_step'

F32 = jnp.float32


def split_cols(a, sizes):
    idx = np.cumsum(sizes)[:-1].tolist()
    return jnp.split(a, idx, axis=-1)


def rmsnorm(x, g):
    xf = x.astype(F32)
    y = xf * lax.rsqrt(jnp.mean(xf * xf, axis=-1, keepdims=True) + NORM_EPS)
    return (y * g.astype(F32)).astype(x.dtype)


def rope(x, pos):
    half = ROT_DIM // 2
    inv_freq = jnp.exp(jnp.arange(half, dtype=F32) * (-math.log(ROPE_THETA) / half))
    ang = pos.astype(F32)[:, None] * inv_freq[None, :]
    cos = jnp.cos(ang)[None, :, None, :]
    sin = jnp.sin(ang)[None, :, None, :]
    xr = x[..., :ROT_DIM].astype(F32)
    x1, x2 = xr[..., :half], xr[..., half:]
    rot = jnp.concatenate([x1 * cos - x2 * sin, x2 * cos + x1 * sin], axis=-1).astype(x.dtype)
    return jnp.concatenate([rot, x[..., ROT_DIM:]], axis=-1)


def attn_probs(s, mask, sink):
    s = jnp.where(mask, s, -jnp.inf)
    m = jnp.max(s, axis=-1, keepdims=True)
    if sink is not None:
        sk = sink.astype(F32)[:, :, None, None]
        m = jnp.maximum(m, sk)
    e = jnp.exp(s - m)
    denom = jnp.sum(e, axis=-1, keepdims=True)
    if sink is not None:
        denom = denom + jnp.exp(sk - m)
    return e / denom, (m + jnp.log(denom))[..., 0]


def band_attention(q, k, v, max_dist, sink=None):
    b, n, g, r, hd = q.shape
    nb = -(-n // BAND)
    pad = nb * BAND - n
    qb = jnp.pad(q, ((0, 0), (0, pad), (0, 0), (0, 0), (0, 0))).reshape(b, nb, BAND, g, r, hd)
    kp = jnp.pad(k, ((0, 0), (BAND, pad), (0, 0), (0, 0))).reshape(b, nb + 1, BAND, g, hd)
    vp = jnp.pad(v, ((0, 0), (BAND, pad), (0, 0), (0, 0))).reshape(b, nb + 1, BAND, g, hd)
    kb = jnp.concatenate([kp[:, :-1], kp[:, 1:]], axis=2)
    vb = jnp.concatenate([vp[:, :-1], vp[:, 1:]], axis=2)
    qi = jnp.arange(BAND)[:, None]
    kj = jnp.arange(2 * BAND)[None, :] - BAND
    dist = qi - kj
    start = (jnp.arange(nb) * BAND)[:, None, None]
    mask = (dist >= 0) & (dist <= max_dist) & (start + kj >= 0)
    s = jnp.einsum('bcqgrd,bckgd->bcgrqk', qb, kb).astype(F32) * (hd ** -0.5)
    p, lse = attn_probs(s, mask[None, :, None, None], sink)
    o = jnp.einsum('bcgrqk,bckgd->bcqgrd', p.astype(v.dtype), vb).reshape(b, nb * BAND, g, r, hd)[:, :n]
    lse = jnp.transpose(lse, (0, 1, 4, 2, 3)).reshape(b, nb * BAND, g, r)[:, :n]
    return o, lse


def window_attention_cached(q, k_new, v_new, k_prev, v_prev, start_pos, sink):
    T = q.shape[1]
    Lb = k_prev.shape[1]
    kc = jnp.concatenate([k_prev.astype(k_new.dtype), k_new], axis=1)
    vc = jnp.concatenate([v_prev.astype(v_new.dtype), v_new], axis=1)
    qpos = start_pos + jnp.arange(T)
    kpos = start_pos - Lb + jnp.arange(Lb + T)
    dist = qpos[:, None] - kpos[None, :]
    mask = (dist >= 0) & (dist < SWA_WINDOW)
    s = jnp.einsum('btgrd,bkgd->bgrtk', q, kc).astype(F32) * (HEAD_DIM ** -0.5)
    p, _ = attn_probs(s, mask, sink)
    return jnp.einsum('bgrtk,bkgd->btgrd', p.astype(vc.dtype), vc)


def dilated_prompt(q, k, v, dil, max_dist):
    b, L = q.shape[:2]
    n = L // dil
    def to_res(a):
        return jnp.swapaxes(a.reshape((b, n, dil) + a.shape[2:]), 1, 2).reshape((b * dil, n) + a.shape[2:])
    def from_res(a):
        return jnp.swapaxes(a.reshape((b, dil, n) + a.shape[2:]), 1, 2).reshape((b, L) + a.shape[2:])
    o, lse = band_attention(to_res(q), to_res(k), to_res(v), max_dist)
    return from_res(o), from_res(lse)


def dilated_cached(q, k_new, v_new, k_prev, v_prev, window, dil):
    T = q.shape[1]
    Lb = k_prev.shape[1]
    nk = window // dil + 1
    j = Lb + jnp.arange(T)[:, None] - dil * jnp.arange(nk)[None, :]
    valid = j >= 0
    sel = (j < Lb)[None, :, :, None, None]
    jp = jnp.clip(j, 0, Lb - 1)
    jn = jnp.clip(j - Lb, 0, T - 1)
    kg = jnp.where(sel, k_prev[:, jp].astype(k_new.dtype), k_new[:, jn])
    vg = jnp.where(sel, v_prev[:, jp].astype(v_new.dtype), v_new[:, jn])
    s = jnp.einsum('btgrd,btkgd->bgrtk', q, kg).astype(F32) * (HEAD_DIM ** -0.5)
    p, lse = attn_probs(s, valid[None, None, None], None)
    o = jnp.einsum('bgrtk,btkgd->btgrd', p.astype(vg.dtype), vg)
    return o, jnp.transpose(lse, (0, 3, 1, 2))


def ssd_scan(x, dt, a, bm, cm, h0):
    b, L, H, P = x.shape
    G, N = bm.shape[2], bm.shape[3]
    R = H // G
    Q = min(SSD_CHUNK, L)
    nc = -(-L // Q)
    pad = nc * Q - L
    def chunks(t, tail):
        t = jnp.pad(t.astype(F32), ((0, 0), (0, pad)) + ((0, 0),) * (t.ndim - 2))
        return t.reshape((b, nc, Q) + tail)
    xc = chunks(x, (G, R, P))
    dtc = chunks(dt, (G, R))
    bc = chunks(bm, (G, N))
    cc = chunks(cm, (G, N))
    la = dtc * a.reshape(G, R)
    acs = jnp.cumsum(la, axis=2)
    xdt = xc * dtc[..., None]
    acs_t = jnp.moveaxis(acs, 2, -1)
    seg = acs_t[..., :, None] - acs_t[..., None, :]
    causal = jnp.tril(jnp.ones((Q, Q), dtype=bool))
    decay = jnp.exp(jnp.where(causal, seg, -jnp.inf))
    cb = jnp.einsum('bclgn,bcsgn->bcgls', cc, bc)
    y_diag = jnp.einsum('bcgrls,bcsgrp->bclgrp', cb[:, :, :, None] * decay, xdt)
    to_end = jnp.exp(acs[:, :, -1:] - acs)
    states = jnp.einsum('bclgn,bclgr,bclgrp->bcgrpn', bc, to_end, xdt)
    chunk_decay = jnp.exp(acs[:, :, -1])
    def step(h, inp):
        st, dec = inp
        return h * dec[..., None, None] + st, h
    h_last, h_in = lax.scan(step, h0.astype(F32).reshape(b, G, R, P, N),
                            (jnp.moveaxis(states, 1, 0), jnp.moveaxis(chunk_decay, 1, 0)))
    h_in = jnp.moveaxis(h_in, 0, 1)
    y_off = jnp.einsum('bclgn,bcgrpn,bclgr->bclgrp', cc, h_in, jnp.exp(acs))
    y = (y_diag + y_off).reshape(b, nc * Q, H, P)[:, :L]
    return y, h_last.reshape(b, H, P, N)


def ssd_branch(z, xbc, dt_raw, conv_prev, ssm_prev, conv_w, conv_b, dt_bias, a_log, d_skip, gate_norm):
    b, L, _ = xbc.shape
    xp = jnp.concatenate([conv_prev.astype(xbc.dtype), xbc], axis=1)
    acc = conv_b
    for i in range(SSD_CONV):
        acc = acc + xp[:, i:i + L] * conv_w[i]
    xbc_c = jax.nn.silu(acc)
    new_conv = xp[:, L:]
    xs, bm, cm = split_cols(xbc_c, (SSD_INNER, SSD_GROUPS * SSD_STATE, SSD_GROUPS * SSD_STATE))
    dt = jax.nn.softplus(dt_raw.astype(F32) + dt_bias.astype(F32))
    a = -jnp.exp(a_log.astype(F32))
    xh = xs.reshape(b, L, SSD_HEADS, SSD_HEADDIM)
    y, h_last = ssd_scan(xh, dt, a, bm.reshape(b, L, SSD_GROUPS, SSD_STATE),
                         cm.reshape(b, L, SSD_GROUPS, SSD_STATE), ssm_prev)
    y = y + d_skip.astype(F32)[:, None] * xh.astype(F32)
    y = y.reshape(b, L, SSD_INNER) * jax.nn.silu(z.astype(F32))
    yg = y.reshape(b, L, SSD_GROUPS, SSD_INNER // SSD_GROUPS)
    yg = yg * lax.rsqrt(jnp.mean(yg * yg, axis=-1, keepdims=True) + NORM_EPS)
    y = yg.reshape(b, L, SSD_INNER) * gate_norm.astype(F32)
    return y.astype(z.dtype), new_conv, h_last


def even_mixer(x, start_pos, conv_prev, ssm_prev, k_prev, v_prev, w_in, conv_w, conv_b,
               dt_bias, a_log, d_skip, gate_norm, sinks, w_out):
    b, L, _ = x.shape
    z, xbc, dt_raw, q, k, v = split_cols(x @ w_in, E_SIZES)
    ssd_out, new_conv, new_ssm = ssd_branch(z, xbc, dt_raw, conv_prev, ssm_prev, conv_w, conv_b,
                                            dt_bias, a_log, d_skip, gate_norm)
    pos = start_pos + jnp.arange(L)
    q = rope(q.reshape(b, L, SWA_HEADS, HEAD_DIM), pos).reshape(b, L, SWA_KV, SWA_REP, HEAD_DIM)
    k = rope(k.reshape(b, L, SWA_KV, HEAD_DIM), pos)
    v = v.reshape(b, L, SWA_KV, HEAD_DIM)
    sink = sinks.reshape(SWA_KV, SWA_REP)
    if k_prev is None:
        att, _ = band_attention(q, k, v, SWA_WINDOW - 1, sink)
        keep = min(SWA_WINDOW, L)
        k_out, v_out = k[:, L - keep:], v[:, L - keep:]
    else:
        att = window_attention_cached(q, k, v, k_prev, v_prev, start_pos, sink)
        k_out, v_out = k, v
    mixed = jnp.concatenate([ssd_out, att.reshape(b, L, SWA_HEADS * HEAD_DIM).astype(ssd_out.dtype)], axis=-1)
    return mixed @ w_out, new_conv, new_ssm, k_out, v_out


def odd_mixer(x, start_pos, k_prev, v_prev, w_in, w_out):
    b, L, _ = x.shape
    q, k, v = split_cols(x @ w_in, O_SIZES)
    pos = start_pos + jnp.arange(L)
    q = rope(q.reshape(b, L, N_DIL * DIL_HEADS, HEAD_DIM), pos).reshape(b, L, N_DIL, DIL_KV, DIL_REP, HEAD_DIM)
    k = rope(k.reshape(b, L, DIL_KV, HEAD_DIM), pos)
    v = v.reshape(b, L, DIL_KV, HEAD_DIM)
    outs, lses = [], []
    for gi, (window, dil) in enumerate(DIL_PATTERNS):
        if k_prev is None:
            o, lse = dilated_prompt(q[:, :, gi], k, v, dil, window // dil)
        else:
            o, lse = dilated_cached(q[:, :, gi], k, v, k_prev, v_prev, window, dil)
        outs.append(o)
        lses.append(lse)
    wts = jax.nn.softmax(jnp.stack(lses), axis=0)
    merged = jnp.einsum('nbtgr,nbtgrd->btgrd', wts, jnp.stack(outs).astype(F32))
    y = merged.reshape(b, L, DIL_HEADS * HEAD_DIM).astype(x.dtype) @ w_out
    if k_prev is None:
        keep = min(DIL_MAX_WINDOW, L)
        k_out, v_out = k[:, L - keep:], v[:, L - keep:]
    else:
        k_out, v_out = k, v
    return y, k_out, v_out


def sq_relu_mlp(x, w1, w2):
    return jnp.square(jax.nn.relu(x @ w1)) @ w2


def run_trunk(x, start_pos, conv_prev, ssm_prev, swa_k_prev, swa_v_prev, dil_k_prev, dil_v_prev,
              norm_mix, norm_mlp, e_w_in, e_conv_w, e_conv_b, e_dt_bias, e_a_log, e_d_skip,
              e_gate_norm, e_sinks, e_w_out, o_w_in, o_w_out, mlp_w1, mlp_w2, norm_final):
    b = x.shape[0]
    cached = conv_prev is not None
    convs, ssms, swa_ks, swa_vs, dil_ks, dil_vs = [], [], [], [], [], []
    h = x
    for layer in range(DEPTH):
        hn = rmsnorm(h, norm_mix[layer])
        if layer % 2 == 0:
            e = layer // 2
            if cached:
                cp, sp, kp, vp = conv_prev[e], ssm_prev[e], swa_k_prev[e], swa_v_prev[e]
            else:
                cp = jnp.zeros((b, SSD_CONV - 1, CONV_DIM), x.dtype)
                sp = jnp.zeros((b, SSD_HEADS, SSD_HEADDIM, SSD_STATE), F32)
                kp, vp = None, None
            y, c_new, s_new, k_new, v_new = even_mixer(
                hn, start_pos, cp, sp, kp, vp, e_w_in[e], e_conv_w[e], e_conv_b[e], e_dt_bias[e],
                e_a_log[e], e_d_skip[e], e_gate_norm[e], e_sinks[e], e_w_out[e])
            convs.append(c_new)
            ssms.append(s_new)
            swa_ks.append(k_new)
            swa_vs.append(v_new)
        else:
            o = layer // 2
            kp = dil_k_prev[o] if cached else None
            vp = dil_v_prev[o] if cached else None
            y, k_new, v_new = odd_mixer(hn, start_pos, kp, vp, o_w_in[o], o_w_out[o])
            dil_ks.append(k_new)
            dil_vs.append(v_new)
        h = h + y
        h = h + sq_relu_mlp(rmsnorm(h, norm_mlp[layer]), mlp_w1[layer], mlp_w2[layer])
    return (rmsnorm(h, norm_final), jnp.stack(convs), jnp.stack(ssms), jnp.stack(swa_ks),
            jnp.stack(swa_vs), jnp.stack(dil_ks), jnp.stack(dil_vs))


def setup_inputs(seed: int = 0) -> dict:
    key = jax.random.key(seed)
    ks = jax.random.split(key, 24)
    def nrm(k, shape, scale):
        return jax.random.normal(k, shape, F32) * scale
    buf_swa = min(SWA_WINDOW, PAST_LEN)
    buf_dil = min(DIL_MAX_WINDOW, PAST_LEN)
    dt0 = jnp.exp(jax.random.uniform(ks[13], (N_EVEN, SSD_HEADS), F32, math.log(1e-3), math.log(1e-1)))
    dt_bias = dt0 + jnp.log(-jnp.expm1(-dt0))
    a_log = jnp.log(jax.random.uniform(ks[14], (N_EVEN, SSD_HEADS), F32, 1.0, 16.0))
    return {
        'x_prompt': nrm(ks[0], (BATCH, SEQ, D_MODEL), 1.0),
        'x_sample': nrm(ks[1], (DEC_BATCH, DEC_SEQ, D_MODEL), 1.0),
        'state_conv': nrm(ks[2], (N_EVEN, DEC_BATCH, SSD_CONV - 1, CONV_DIM), 1.0),
        'state_ssm': nrm(ks[3], (N_EVEN, DEC_BATCH, SSD_HEADS, SSD_HEADDIM, SSD_STATE), 0.1),
        'cache_swa_k': nrm(ks[4], (N_EVEN, DEC_BATCH, buf_swa, SWA_KV, HEAD_DIM), 1.0),
        'cache_swa_v': nrm(ks[5], (N_EVEN, DEC_BATCH, buf_swa, SWA_KV, HEAD_DIM), 1.0),
        'cache_dil_k': nrm(ks[6], (N_ODD, DEC_BATCH, buf_dil, DIL_KV, HEAD_DIM), 1.0),
        'cache_dil_v': nrm(ks[7], (N_ODD, DEC_BATCH, buf_dil, DIL_KV, HEAD_DIM), 1.0),
        'norm_mix': 1.0 + nrm(ks[8], (DEPTH, D_MODEL), 0.02),
        'norm_mlp': 1.0 + nrm(ks[9], (DEPTH, D_MODEL), 0.02),
        'e_w_in': nrm(ks[10], (N_EVEN, D_MODEL, E_IN), D_MODEL ** -0.5),
        'e_conv_w': nrm(ks[11], (N_EVEN, SSD_CONV, CONV_DIM), SSD_CONV ** -0.5),
        'e_conv_b': nrm(ks[12], (N_EVEN, CONV_DIM), 0.02),
        'e_dt_bias': dt_bias,
        'e_a_log': a_log,
        'e_d_skip': 1.0 + nrm(ks[15], (N_EVEN, SSD_HEADS), 0.02),
        'e_gate_norm': 1.0 + nrm(ks[16], (N_EVEN, SSD_INNER), 0.02),
        'e_sinks': nrm(ks[17], (N_EVEN, SWA_HEADS), 0.5),
        'e_w_out': nrm(ks[18], (N_EVEN, E_OUT, D_MODEL), E_OUT ** -0.5),
        'o_w_in': nrm(ks[19], (N_ODD, D_MODEL, O_IN), D_MODEL ** -0.5),
        'o_w_out': nrm(ks[20], (N_ODD, O_OUT, D_MODEL), O_OUT ** -0.5),
        'mlp_w1': nrm(ks[21], (DEPTH, D_MODEL, MLP_HIDDEN), D_MODEL ** -0.5),
        'mlp_w2': nrm(ks[22], (DEPTH, MLP_HIDDEN, D_MODEL), MLP_HIDDEN ** -0.5),
        'norm_final': 1.0 + nrm(ks[23], (D_MODEL,), 0.02),
    }


def reference(x_prompt, x_sample, state_conv, state_ssm, cache_swa_k, cache_swa_v, cache_dil_k, cache_dil_v,
              norm_mix, norm_mlp, e_w_in, e_conv_w, e_conv_b, e_dt_bias, e_a_log, e_d_skip, e_gate_norm,
              e_sinks, e_w_out, o_w_in, o_w_out, mlp_w1, mlp_w2, norm_final):
    weights = (norm_mix, norm_mlp, e_w_in, e_conv_w, e_conv_b, e_dt_bias, e_a_log, e_d_skip, e_gate_norm,
               e_sinks, e_w_out, o_w_in, o_w_out, mlp_w1, mlp_w2, norm_final)
    y_prompt, p_conv, p_ssm, p_swa_k, p_swa_v, p_dil_k, p_dil_v = run_trunk(
        x_prompt, 0, None, None, None, None, None, None, *weights)
    y_sample, s_conv, s_ssm, s_swa_k, s_swa_v, s_dil_k, s_dil_v = run_trunk(
        x_sample, PAST_LEN, state_conv, state_ssm, cache_swa_k, cache_swa_v, cache_dil_k, cache_dil_v, *weights)
    return (y_prompt, y_sample, p_conv, p_ssm, p_swa_k, p_swa_v, p_dil_k, p_dil_v,
            s_conv, s_ssm, s_swa_k, s_swa_v, s_dil_k, s_dil_v)
```

```cpp
#include <hip/hip_runtime.h>
#include <cstdio>
#include <cstdint>

#define GAS __attribute__((address_space(1)))
#define LAS __attribute__((address_space(3)))
typedef unsigned short bf16;
typedef unsigned v4u __attribute__((ext_vector_type(4)));
typedef unsigned v2u __attribute__((ext_vector_type(2)));
typedef float f32x2 __attribute__((ext_vector_type(2)));
typedef float f32x4 __attribute__((ext_vector_type(4)));
typedef float f32x16 __attribute__((ext_vector_type(16)));
typedef short bf16x8 __attribute__((ext_vector_type(8)));
typedef short s16x4 __attribute__((ext_vector_type(4)));
typedef __bf16 bf16x2_t __attribute__((ext_vector_type(2)));
typedef GAS unsigned gu32;
#define RLX_AGENT __ATOMIC_RELAXED, __HIP_MEMORY_SCOPE_AGENT
#define DI __device__ __forceinline__

DI unsigned pk2(float lo, float hi) { f32x2 v = {lo, hi}; bf16x2_t b = __builtin_convertvector(v, bf16x2_t); return __builtin_bit_cast(unsigned, b); }
DI float bflo(unsigned u) { return __uint_as_float(u << 16); }
DI float bfhi(unsigned u) { return __uint_as_float(u & 0xffff0000u); }
DI float wave_sum(float v) {
#pragma unroll
    for (int o = 1; o < 64; o <<= 1) v += __shfl_xor(v, o);
    return v;
}
DI int crow(int reg, int h) { return (reg & 3) + 8 * (reg >> 2) + 4 * h; }
#define MFMA32(a, b, c) __builtin_amdgcn_mfma_f32_32x32x16_bf16((a), (b), (c), 0, 0, 0)
DI s16x4 trr(const LAS unsigned char* p) { return __builtin_bit_cast(s16x4, __builtin_amdgcn_ds_read_tr16_b64_v4i16((LAS s16x4*)p)); }
DI bf16x8 cat8(s16x4 lo, s16x4 hi) { return __builtin_shufflevector(lo, hi, 0, 1, 2, 3, 4, 5, 6, 7); }
DI bf16x8 pack8(float a0, float a1, float a2, float a3, float a4, float a5, float a6, float a7) {
    v4u p; p.x = pk2(a0, a1); p.y = pk2(a2, a3); p.z = pk2(a4, a5); p.w = pk2(a6, a7); return __builtin_bit_cast(bf16x8, p);
}
DI float fexp2(float x) { return __builtin_amdgcn_exp2f(x); }
DI float fexp(float x) { return __builtin_amdgcn_exp2f(x * 1.4426950408889634f); }
DI float sigmoidf_(float x) { return 1.0f / (1.0f + fexp(-x)); }
DI float siluf_(float x) { return x * sigmoidf_(x); }
DI float softplusf_(float x) { return x > 20.f ? x : log1pf(__expf(x)); }

namespace pg8 {
#define PG8_LAS __attribute__((address_space(3)))
typedef unsigned short bf16_t;
typedef short bf16x8 __attribute__((ext_vector_type(8)));
typedef float f32x4 __attribute__((ext_vector_type(4)));
typedef unsigned u32x4 __attribute__((ext_vector_type(4)));
constexpr int BM = 256, BK = 64, HALF = 128, HTB = HALF * BK * 2  , STAGE_BYTES = 8 * HTB, NXCD = 8, WGM = 8;

__host__ __device__ __forceinline__ int lds_byte(int r, int c) { const int st = (r >> 4) * 2 + (c >> 5), rr = r & 15, cc = c & 31, ob = rr * 64 + cc * 2; return st * 1024 + (ob ^ (((ob >> 9) & 1) << 5)); }
__host__ __device__ __forceinline__ void stage_rc(int b, int& R, int& C) { const int st = b / 1024, sb = b % 1024, swz = sb ^ (((sb >> 9) & 1) << 5); R = (st >> 1) * 16 + swz / 64; C = (st & 1) * 32 + (swz % 64) / 2; }
__host__ __device__ __forceinline__ int perm32(int rho) { const int n = rho >> 4, i = rho & 15; return 8 * (i >> 2) + 4 * n + (i & 3); }

struct Unit { int pm, pn; };
struct Gemm { const bf16_t* A; const bf16_t* Bt; int M, N, K; };

struct StaticOrder {
    int nM, nN, nwg, G, c;
    __host__ __device__ void init(int M, int N, int G_, int c_) { nM = M / BM; nN = N / BM; nwg = nM * nN; G = G_; c = c_; }
    __host__ __device__ bool next(int i, Unit& u) const {
        const long L = (long)i * G + c; if (L >= nwg) return false;
        int wgid = (int)L; { const int q = nwg / NXCD, r = nwg % NXCD, xcd = wgid % NXCD, off = wgid / NXCD; wgid = (xcd < r ? xcd * (q + 1) : r * (q + 1) + (xcd - r) * q) + off; }
        const int nig = WGM * nN, gid = wgid / nig, fm = gid * WGM, gsz = (nM - fm) < WGM ? (nM - fm) : WGM;
        u.pm = fm + ((wgid % nig) % gsz); u.pn = (wgid % nig) / gsz; return true;
    }
    __device__ __forceinline__ void a_ready(const Unit&) const {}
    __device__ __forceinline__ void done(const Unit&) const {}
};

template <class Epi, class Sched, bool ALIGN_EPI = false, bool SP2 = false>
__device__ __forceinline__ void gemm_phase(PG8_LAS unsigned char* lds, const Gemm g, const Sched& S, const Epi& E) {
    const int tid = threadIdx.x, wid = __builtin_amdgcn_readfirstlane(tid >> 6), lane = tid & 63, wr = wid >> 2, wc = wid & 3, fr = lane & 15, fq = lane >> 4;
    const int K = g.K, nt = K / BK;
    unsigned voffA[2], voffB[2];
#pragma unroll
    for (int i = 0; i < 2; ++i) { int R, C; stage_rc(tid * 16 + i * 8192, R, C); const int Rb = Epi::PERM ? ((R & ~31) + perm32(R & 31)) : R;
        voffA[i] = (unsigned)(R * K + C) * 2u; voffB[i] = (unsigned)(Rb * K + C) * 2u; }
    const size_t kstep = (size_t)(BK * 2);
    const size_t hstep = (size_t)HALF * K * 2;
    const size_t tstep = 2 * hstep;
    const unsigned ldsw = (unsigned)wid * 1024u;
    const int aoff = lds_byte(wr * 64 + fr, fq * 8), boff = lds_byte(wc * 32 + fr, fq * 8);
#define PG8_SA(b, h) (((b) * 2 + (h)) * HTB)
#define PG8_SB(b, h) ((4 + (b) * 2 + (h)) * HTB)
#define PG8_STAGE(bufoff, gbase, voff) do { _Pragma("unroll") for (int _i = 0; _i < 2; ++_i) \
        __builtin_amdgcn_global_load_lds((const unsigned*)((const char*)(gbase) + (voff)[_i]), (PG8_LAS unsigned*)(lds + (bufoff) + ldsw + _i * 8192), 16, 0, 0); } while (0)
#define PG8_LDA(dst, b, h) do { _Pragma("unroll") for (int m = 0; m < 4; ++m) _Pragma("unroll") for (int k = 0; k < 2; ++k) dst[m][k] = *(const PG8_LAS bf16x8*)(lds + PG8_SA(b, h) + aoff + m * 2048 + k * 1024); } while (0)
#define PG8_LDB(dst, b, h) do { _Pragma("unroll") for (int n = 0; n < 2; ++n) _Pragma("unroll") for (int k = 0; k < 2; ++k) dst[n][k] = *(const PG8_LAS bf16x8*)(lds + PG8_SB(b, h) + boff + n * 2048 + k * 1024); } while (0)
#define PG8_MMA(ai, bj, At, Bt) do { __builtin_amdgcn_s_setprio(1); _Pragma("unroll") for (int m = 0; m < 4; ++m) _Pragma("unroll") for (int n = 0; n < 2; ++n) _Pragma("unroll") for (int k = 0; k < 2; ++k) \
        acc[ai][bj][m][n] = __builtin_amdgcn_mfma_f32_16x16x32_bf16(Bt[n][k], At[m][k], acc[ai][bj][m][n], 0, 0, 0); __builtin_amdgcn_s_setprio(0); } while (0)
#define PG8_WAIT_V(n) asm volatile("s_waitcnt vmcnt(" #n ")" ::: "memory")
#define PG8_WAIT_L(n) asm volatile("s_waitcnt lgkmcnt(" #n ")" ::: "memory")
#define PG8_BAR __builtin_amdgcn_s_barrier()
#define PG8_SCHED __builtin_amdgcn_sched_barrier(0)
    Unit cur, nxt; int ui = 0;
    if (!S.next(0, cur)) return;
    f32x4 acc[2][2][4][2];
#pragma unroll
    for (int a = 0; a < 2; ++a)
#pragma unroll
        for (int b = 0; b < 2; ++b)
#pragma unroll
            for (int m = 0; m < 4; ++m)
#pragma unroll
                for (int n = 0; n < 2; ++n) acc[a][b][m][n] = (f32x4){0.f, 0.f, 0.f, 0.f};
    bf16x8 At[4][2], B0[2][2], B1[2][2];
    const char* cA = (const char*)g.A + (size_t)cur.pm * tstep; const char* cB = (const char*)g.Bt + (size_t)cur.pn * tstep;
    S.a_ready(cur);
    if constexpr (SP2) {
        PG8_STAGE(PG8_SB(0, 0), cB, voffB); PG8_STAGE(PG8_SB(0, 1), cB + hstep, voffB); PG8_STAGE(PG8_SA(0, 0), cA, voffA); PG8_STAGE(PG8_SA(0, 1), cA + hstep, voffA);
        if (wr == 1) PG8_BAR;
        PG8_WAIT_V(2); PG8_BAR;
        PG8_STAGE(PG8_SB(1, 0), cB + kstep, voffB); PG8_STAGE(PG8_SA(1, 0), cA + kstep, voffA); PG8_STAGE(PG8_SB(1, 1), cB + hstep + kstep, voffB);
        PG8_WAIT_V(6); PG8_BAR;
    } else {
        PG8_STAGE(PG8_SB(0, 0), cB, voffB); PG8_STAGE(PG8_SA(0, 0), cA, voffA); PG8_STAGE(PG8_SB(0, 1), cB + hstep, voffB); PG8_STAGE(PG8_SA(0, 1), cA + hstep, voffA);
        if (wr == 1) PG8_BAR;
        PG8_WAIT_V(4); PG8_BAR;
        PG8_STAGE(PG8_SB(1, 0), cB + kstep, voffB); PG8_STAGE(PG8_SA(1, 0), cA + kstep, voffA); PG8_STAGE(PG8_SB(1, 1), cB + hstep + kstep, voffB);
        PG8_WAIT_V(6); PG8_BAR;
    }
    for (;;) {
        const bool has_next = S.next(ui + 1, nxt);
        const char* nA = has_next ? (const char*)g.A + (size_t)nxt.pm * tstep : cA; const char* nB = has_next ? (const char*)g.Bt + (size_t)nxt.pn * tstep : cB;
        for (int t = 0; t < nt; t += 2) {
            const bool last = (t == nt - 2);
            const char* a1 = cA + (size_t)(t + 1) * kstep;
            const char* a2 = last ? nA : cA + (size_t)(t + 2) * kstep; const char* b2 = last ? nB : cB + (size_t)(t + 2) * kstep;
            const char* a3 = a2 + kstep; const char* b3 = b2 + kstep;
            if (last && has_next) S.a_ready(nxt);
            if constexpr (SP2) {
            PG8_LDB(B0, 0, 0); PG8_LDB(B1, 0, 1); PG8_SCHED; PG8_LDA(At, 0, 0); PG8_STAGE(PG8_SA(1, 1), a1 + hstep, voffA);
            PG8_WAIT_V(8); PG8_WAIT_L(0); PG8_BAR; PG8_MMA(0, 0, At, B0); PG8_MMA(0, 1, At, B1); PG8_BAR; PG8_SCHED;
            PG8_LDA(At, 0, 1); PG8_STAGE(PG8_SB(0, 0), b2, voffB); PG8_STAGE(PG8_SB(0, 1), b2 + hstep, voffB); PG8_STAGE(PG8_SA(0, 0), a2, voffA);
            PG8_WAIT_V(8); PG8_WAIT_L(0); PG8_BAR; PG8_MMA(1, 0, At, B0); PG8_MMA(1, 1, At, B1); PG8_BAR; PG8_SCHED;
            PG8_LDB(B0, 1, 0); PG8_LDB(B1, 1, 1); PG8_SCHED; PG8_LDA(At, 1, 0); PG8_STAGE(PG8_SA(0, 1), a2 + hstep, voffA);
            PG8_WAIT_V(8); PG8_WAIT_L(0); PG8_BAR; PG8_MMA(0, 0, At, B0); PG8_MMA(0, 1, At, B1); PG8_BAR; PG8_SCHED;
            PG8_LDA(At, 1, 1); PG8_STAGE(PG8_SB(1, 0), b3, voffB); PG8_STAGE(PG8_SB(1, 1), b3 + hstep, voffB); PG8_STAGE(PG8_SA(1, 0), a3, voffA);
            PG8_WAIT_V(8); PG8_WAIT_L(0); PG8_BAR; PG8_MMA(1, 0, At, B0); PG8_MMA(1, 1, At, B1); PG8_BAR; PG8_SCHED;
            } else {
            PG8_LDB(B0, 0, 0); PG8_SCHED; PG8_LDA(At, 0, 0); PG8_STAGE(PG8_SA(1, 1), a1 + hstep, voffA);
            PG8_WAIT_L(8); PG8_BAR; PG8_WAIT_L(0); PG8_MMA(0, 0, At, B0); PG8_BAR; PG8_SCHED;
            PG8_LDB(B1, 0, 1); PG8_STAGE(PG8_SB(0, 0), b2, voffB);
            PG8_BAR; PG8_WAIT_L(0); PG8_MMA(0, 1, At, B1); PG8_BAR;
            PG8_LDA(At, 0, 1); PG8_STAGE(PG8_SA(0, 0), a2, voffA);
            PG8_BAR; PG8_WAIT_L(0); PG8_MMA(1, 0, At, B0); PG8_BAR; PG8_SCHED;
            PG8_STAGE(PG8_SB(0, 1), b2 + hstep, voffB);
            PG8_WAIT_V(6); PG8_BAR; PG8_MMA(1, 1, At, B1); PG8_BAR;
            PG8_LDB(B0, 1, 0); PG8_SCHED; PG8_LDA(At, 1, 0); PG8_STAGE(PG8_SA(0, 1), a2 + hstep, voffA);
            PG8_WAIT_L(8); PG8_BAR; PG8_WAIT_L(0); PG8_MMA(0, 0, At, B0); PG8_BAR; PG8_SCHED;
            PG8_LDB(B1, 1, 1); PG8_STAGE(PG8_SB(1, 0), b3, voffB);
            PG8_BAR; PG8_WAIT_L(0); PG8_MMA(0, 1, At, B1); PG8_BAR;
            PG8_LDA(At, 1, 1); PG8_STAGE(PG8_SA(1, 0), a3, voffA);
            PG8_BAR; PG8_WAIT_L(0); PG8_MMA(1, 0, At, B0); PG8_BAR; PG8_SCHED;
            PG8_STAGE(PG8_SB(1, 1), b3 + hstep, voffB);
            PG8_WAIT_V(6); PG8_BAR; PG8_MMA(1, 1, At, B1); PG8_BAR;
            }
        }
        if constexpr (ALIGN_EPI) { if (wr == 0) PG8_BAR; }
        if constexpr (!Epi::AFTER_DRAIN) { E(acc, cur, wr, wc, fr, fq); S.done(cur); }
        if (!has_next) break;
#pragma unroll
        for (int a = 0; a < 2; ++a)
#pragma unroll
            for (int b = 0; b < 2; ++b)
#pragma unroll
                for (int m = 0; m < 4; ++m)
#pragma unroll
                    for (int n = 0; n < 2; ++n) acc[a][b][m][n] = (f32x4){0.f, 0.f, 0.f, 0.f};
        cur = nxt; cA = nA; cB = nB; ++ui;
        if constexpr (ALIGN_EPI) { if (wr == 1) PG8_BAR; }
    }
    PG8_WAIT_V(0);
    if constexpr (!ALIGN_EPI) { if (wr == 0) PG8_BAR; }
    PG8_BAR;
    if constexpr (Epi::AFTER_DRAIN) { E.fused(acc, cur, wr, wc, fr, fq, lds, wid, lane); S.done(cur); }
#undef PG8_SA
#undef PG8_SB
#undef PG8_STAGE
#undef PG8_LDA
#undef PG8_LDB
#undef PG8_MMA
#undef PG8_WAIT_V
#undef PG8_WAIT_L
#undef PG8_BAR
#undef PG8_SCHED
}
}

constexpr int NWAVES = 8, NTHR = 512;
constexpr int DM = 2048, MP = 8192, MS = 512, MROWS = MP + MS;
constexpr int N1 = 8448, N5 = 7168, FF = 8192, KMIX = 4096;
constexpr int C_Z = 0, C_XBC = 2048, C_Q = 5120, C_K = 7168, C_V = 7680, C_DT = 8192;
constexpr int O_Q = 0, O_K = 6144, O_V = 6656;
constexpr int CONVD = 3072;
constexpr float EPS = 1e-5f;
constexpr int NPH = 18;
#ifndef MK_ONE_LAUNCH
#define MK_ONE_LAUNCH 1
#endif

constexpr size_t OUT_YP = 0, OUT_YS = OUT_YP + (size_t)MP * DM, OUT_PCONV = OUT_YS + (size_t)MS * DM, OUT_PSSM = OUT_PCONV + 3 * CONVD,
    OUT_PSWAK = OUT_PSSM + 32 * 64 * 128, OUT_PSWAV = OUT_PSWAK + 128 * 512, OUT_PDILK = OUT_PSWAV + 128 * 512, OUT_PDILV = OUT_PDILK + 2048 * 512,
    OUT_SCONV = OUT_PDILV + 2048 * 512, OUT_SSSM = OUT_SCONV + 128 * 3 * CONVD, OUT_SSWAK = OUT_SSSM + (size_t)128 * 32 * 64 * 128,
    OUT_SSWAV = OUT_SSWAK + 512 * 512, OUT_SDILK = OUT_SSWAV + 512 * 512, OUT_SDILV = OUT_SDILK + 512 * 512, OUT_END = OUT_SDILV + 512 * 512;

constexpr size_t MiB = 1u << 20;
constexpr size_t WS_CTL = 0, CTL_ZERO_BYTES = 1 * MiB;
constexpr size_t WS_ROPE = 1 * MiB, WS_DT = 2 * MiB, WS_CD = 4 * MiB, WS_LSE = 5 * MiB;
constexpr size_t WS_W1T = 16 * MiB, WS_W2T = 50 * MiB, WS_WM1T = 66 * MiB, WS_WM2T = 130 * MiB, WS_W5T = 194 * MiB, WS_W6T = 222 * MiB;
constexpr size_t WS_XN = 230 * MiB, WS_P1 = 264 * MiB, WS_XC = 405 * MiB, WS_ST = 453 * MiB, WS_HIN = 517 * MiB, WS_MIX = 549 * MiB, WS_H = 617 * MiB;
constexpr size_t WS_U = 685 * MiB, WS_P5 = 821 * MiB, WS_O3 = 940 * MiB, WS_MRG = 1042 * MiB, WS_END = 1076 * MiB;
static_assert(WS_W1T + (size_t)N1 * DM * 2 <= WS_W2T && WS_P1 + (size_t)MROWS * N1 * 2 <= WS_XC && WS_U + (size_t)MROWS * FF * 2 <= WS_P5 && WS_P5 + (size_t)MROWS * N5 * 2 <= WS_O3 && WS_O3 + (size_t)3 * MROWS * DM * 2 <= WS_MRG, "ws map");
constexpr int CW_TMO = 0, CW_BAR = 4096;

constexpr int LDS_BYTES = 163840 - 1024;
constexpr int MISC_OFF = LDS_BYTES - 256;

#define XB_LAS_DEFINED 1
#define XB_TMO      128
#define XB_XCNT(j)  (256  + 64 * (j))
#define XB_XSUB(j)  (1280 + 64 * (j))
#define XB_XGEN(j)  (2304 + 64 * (j))
#define XB_TOP      3328
#define XB_TOPGEN   3392
#define XCD_BAR_WORDS 3456
#define XB_SPIN_CAP (1u << 18)

__device__ __forceinline__ unsigned xb_ld(unsigned* p)              { return __hip_atomic_load(p, __ATOMIC_RELAXED, __HIP_MEMORY_SCOPE_AGENT); }
__device__ __forceinline__ unsigned xb_add(unsigned* p, unsigned v) { return __hip_atomic_fetch_add(p, v, __ATOMIC_RELAXED, __HIP_MEMORY_SCOPE_AGENT); }
__device__ __forceinline__ unsigned xb_xcc_id() { return (unsigned)__builtin_amdgcn_s_getreg((3 << 11) | 20) & 0xFu; }
#define XB_SPIN(cond, bar) do { unsigned _sp = 0; while (cond) { __builtin_amdgcn_s_sleep(1); \
    if ((++_sp & 255u) == 0u) { if (xb_ld(&(bar)[XB_TMO])) break; if (_sp > XB_SPIN_CAP) { atomicAdd(&(bar)[XB_TMO], 1u); break; } } } } while (0)

struct XcdBarrier {
    unsigned* bar; unsigned x;
    volatile LAS unsigned* st;
};

__device__ __forceinline__ XcdBarrier xcd_barrier_post(unsigned* bar, volatile LAS unsigned* st) {
    XcdBarrier b; b.bar = bar; b.x = xb_xcc_id(); b.st = st;
    if (threadIdx.x == 0) (void)xb_add(&bar[XB_XCNT(b.x)], 1u);
    return b;
}
__device__ __forceinline__ void xcd_barrier_complete(unsigned* bar, unsigned x, unsigned& nloc, unsigned& nx) {
    const unsigned G = gridDim.x * gridDim.y * gridDim.z;
    unsigned sum, cnt, mine, sp = 0u;
    for (;;) {
        sum = 0u; cnt = 0u; mine = 0u;
#pragma unroll
        for (unsigned j = 0; j < 16; ++j) { const unsigned c = xb_ld(&bar[XB_XCNT(j)]); sum += c; cnt += (c > 0u) ? 1u : 0u; mine = (j == x) ? c : mine; }
        if (sum == G) break;
        __builtin_amdgcn_s_sleep(1);
        if ((++sp & 255u) == 0u) { if (xb_ld(&bar[XB_TMO])) break; if (sp > XB_SPIN_CAP) { atomicAdd(&bar[XB_TMO], 1u); break; } }
    }
    nloc = mine > 0u ? mine : 1u; nx = cnt > 0u ? cnt : 1u;
}

__device__ __forceinline__ void xcd_barrier(const XcdBarrier& b) {
    asm volatile("s_waitcnt vmcnt(0)" ::: "memory");
    __syncthreads();
    if (threadIdx.x == 0) {
        unsigned* bar = b.bar;
        __builtin_amdgcn_s_waitcnt(0);
        unsigned nloc = b.st[0], nx = b.st[1];
        if (nloc == 0u) { xcd_barrier_complete(bar, b.x, nloc, nx); b.st[0] = nloc; b.st[1] = nx; }
        const unsigned old = xb_add(&bar[XB_XSUB(b.x)], 1u);
        const unsigned gen = old / nloc;
        if (old + 1u == (gen + 1u) * nloc) {
            __builtin_amdgcn_fence(__ATOMIC_RELEASE, "agent");
            asm volatile("s_waitcnt vmcnt(0)" ::: "memory");
            const unsigned og = xb_add(&bar[XB_TOP], 1u);
            const unsigned tg = og / nx;
            if (og + 1u == (tg + 1u) * nx) xb_add(&bar[XB_TOPGEN], 1u);
            else XB_SPIN(xb_ld(&bar[XB_TOPGEN]) == tg, bar);
            __builtin_amdgcn_fence(__ATOMIC_ACQUIRE, "agent");
            xb_add(&bar[XB_XGEN(b.x)], 1u);
            asm volatile("s_waitcnt vmcnt(0)" ::: "memory");
        } else {
            XB_SPIN(xb_ld(&bar[XB_XGEN(b.x)]) == gen, bar);
            __builtin_amdgcn_fence(__ATOMIC_ACQUIRE, "agent");
            asm volatile("s_waitcnt vmcnt(0)" ::: "memory");
        }
    }
    __syncthreads();
}

namespace pg8 {
DI void st_bf16x8(bf16* p, f32x4 v0, f32x4 v1) { v4u w; w.x = pk2(v0[0], v0[1]); w.y = pk2(v0[2], v0[3]); w.z = pk2(v1[0], v1[1]); w.w = pk2(v1[2], v1[3]); *(v4u*)p = w; }
DI void st_f32x8(float* p, f32x4 v0, f32x4 v1) { *(f32x4*)p = v0; *(f32x4*)(p + 4) = v1; }
DI int row_pos(int r) { return r < MP ? r : MP + (r & 3); }
DI void rope8(f32x4& v0, f32x4& v1, const float* rope, int pos, int fq) {
    f32x4 o0, o1;
#pragma unroll
    for (int e = 0; e < 4; ++e) { o0[e] = __shfl_xor(v0[e], 16); o1[e] = __shfl_xor(v1[e], 16); }
    if (fq < 2) {
        const f32x4 c0 = *(const f32x4*)(rope + pos * 16), c1 = *(const f32x4*)(rope + pos * 16 + 4), s0 = *(const f32x4*)(rope + pos * 16 + 8), s1 = *(const f32x4*)(rope + pos * 16 + 12);
        const float sg = fq == 0 ? -1.f : 1.f;
        v0 = v0 * c0 + (o0 * s0) * sg; v1 = v1 * c1 + (o1 * s1) * sg;
    }
}
struct EpiProj1 {
    static constexpr bool PERM = true, AFTER_DRAIN = false;
    bf16* P1; float* DT; const float* rope; float* out;
    DI void operator()(const f32x4 (&acc)[2][2][4][2], const Unit& u, int wr, int wc, int fr, int fq) const {
        const int pn = u.pn, row0 = u.pm * BM + wr * 64 + fr;
        if (pn == 32) {
            if (wc == 0) {
#pragma unroll
                for (int ai = 0; ai < 2; ++ai)
#pragma unroll
                    for (int m = 0; m < 4; ++m) { const int r = row0 + ai * HALF + m * 16; st_f32x8(DT + (size_t)r * 32 + 8 * fq, acc[ai][0][m][0], acc[ai][0][m][1]); }
            }
            return;
        }
        const bool dorope = (pn >= 20 && pn < 30) && ((wc & 1) == 0);
#pragma unroll
        for (int ai = 0; ai < 2; ++ai)
#pragma unroll
            for (int m = 0; m < 4; ++m) {
                const int r = row0 + ai * HALF + m * 16, pos = row_pos(r);
#pragma unroll
                for (int bj = 0; bj < 2; ++bj) {
                    const int cb = pn * BM + bj * HALF + wc * 32 + 8 * fq;
                    f32x4 v0 = acc[ai][bj][m][0], v1 = acc[ai][bj][m][1];
                    if (dorope) rope8(v0, v1, rope, pos, fq);
                    st_bf16x8(P1 + (size_t)r * N1 + cb, v0, v1);
                    if (u.pm >= 31) {
                        if (pn >= 8 && pn < 20) {
                            const int c = cb - C_XBC;
                            if (r >= MP - 3 && r < MP) st_f32x8(out + OUT_PCONV + (size_t)(r - (MP - 3)) * CONVD + c, v0, v1);
                            if (r >= MP) { const int t = (r - MP) & 3, b = (r - MP) >> 2; if (t >= 1) st_f32x8(out + OUT_SCONV + ((size_t)b * 3 + (t - 1)) * CONVD + c, v0, v1); }
                        } else if (pn >= 28 && pn < 30) {
                            const int c = cb - C_K;
                            if (r >= MP - 128 && r < MP) st_f32x8(out + OUT_PSWAK + (size_t)(r - (MP - 128)) * 512 + c, v0, v1);
                            if (r >= MP) st_f32x8(out + OUT_SSWAK + (size_t)(r - MP) * 512 + c, v0, v1);
                        } else if (pn >= 30) {
                            const int c = cb - C_V;
                            if (r >= MP - 128 && r < MP) st_f32x8(out + OUT_PSWAV + (size_t)(r - (MP - 128)) * 512 + c, v0, v1);
                            if (r >= MP) st_f32x8(out + OUT_SSWAV + (size_t)(r - MP) * 512 + c, v0, v1);
                        }
                    }
                }
            }
    }
};
struct EpiProj5 {
    static constexpr bool PERM = true, AFTER_DRAIN = false;
    bf16* P5; const float* rope; float* out;
    DI void operator()(const f32x4 (&acc)[2][2][4][2], const Unit& u, int wr, int wc, int fr, int fq) const {
        const int pn = u.pn, row0 = u.pm * BM + wr * 64 + fr;
        const bool dorope = (pn < 26) && ((wc & 1) == 0);
#pragma unroll
        for (int ai = 0; ai < 2; ++ai)
#pragma unroll
            for (int m = 0; m < 4; ++m) {
                const int r = row0 + ai * HALF + m * 16, pos = row_pos(r);
#pragma unroll
                for (int bj = 0; bj < 2; ++bj) {
                    const int cb = pn * BM + bj * HALF + wc * 32 + 8 * fq;
                    f32x4 v0 = acc[ai][bj][m][0], v1 = acc[ai][bj][m][1];
                    if (dorope) rope8(v0, v1, rope, pos, fq);
                    st_bf16x8(P5 + (size_t)r * N5 + cb, v0, v1);
                    if (u.pm >= 24 && pn >= 24) {
                        const bool isk = pn < 26; const int c = cb - (isk ? O_K : O_V);
                        if (r >= MP - 2048 && r < MP) st_f32x8(out + (isk ? OUT_PDILK : OUT_PDILV) + (size_t)(r - (MP - 2048)) * 512 + c, v0, v1);
                        if (r >= MP) st_f32x8(out + (isk ? OUT_SDILK : OUT_SDILV) + (size_t)(r - MP) * 512 + c, v0, v1);
                    }
                }
            }
    }
};
struct EpiRes {
    static constexpr bool PERM = true, AFTER_DRAIN = false;
    const float* resP; const float* resS; float* H;
    DI void operator()(const f32x4 (&acc)[2][2][4][2], const Unit& u, int wr, int wc, int fr, int fq) const {
        const int row0 = u.pm * BM + wr * 64 + fr;
#pragma unroll
        for (int ai = 0; ai < 2; ++ai)
#pragma unroll
            for (int m = 0; m < 4; ++m) {
                const int r = row0 + ai * HALF + m * 16;
                const float* rp = (r < MP) ? resP + (size_t)r * DM : resS + (size_t)(r - MP) * DM;
#pragma unroll
                for (int bj = 0; bj < 2; ++bj) {
                    const int cb = u.pn * BM + bj * HALF + wc * 32 + 8 * fq;
                    const f32x4 a0 = *(const f32x4*)(rp + cb), a1 = *(const f32x4*)(rp + cb + 4);
                    st_f32x8(H + (size_t)r * DM + cb, acc[ai][bj][m][0] + a0, acc[ai][bj][m][1] + a1);
                }
            }
    }
};
struct EpiSq {
    static constexpr bool PERM = true, AFTER_DRAIN = false;
    bf16* U;
    DI void operator()(const f32x4 (&acc)[2][2][4][2], const Unit& u, int wr, int wc, int fr, int fq) const {
        const int row0 = u.pm * BM + wr * 64 + fr;
#pragma unroll
        for (int ai = 0; ai < 2; ++ai)
#pragma unroll
            for (int m = 0; m < 4; ++m) {
                const int r = row0 + ai * HALF + m * 16;
#pragma unroll
                for (int bj = 0; bj < 2; ++bj) {
                    const int cb = u.pn * BM + bj * HALF + wc * 32 + 8 * fq;
                    f32x4 v0 = acc[ai][bj][m][0], v1 = acc[ai][bj][m][1];
#pragma unroll
                    for (int e = 0; e < 4; ++e) { const float a = fmaxf(v0[e], 0.f), b = fmaxf(v1[e], 0.f); v0[e] = a * a; v1[e] = b * b; }
                    st_bf16x8(U + (size_t)r * FF + cb, v0, v1);
                }
            }
    }
};
}

struct Frame {
    LAS unsigned char* lds;
    int tid, lane, wave, G, bid;
    const float* const* in; float* out; unsigned char* ws;
};
#define LDS_WAIT() asm volatile("s_waitcnt lgkmcnt(0)" ::: "memory")

DI void transpose_item(const float* W, int N, bf16* WT, int K, int k0, int n0, int drow0, LAS float* scr, int lane) {
#pragma unroll 8
    for (int i = 0; i < 32; ++i) { const int kk = 2 * i + (lane >> 5); scr[kk * 33 + (lane & 31)] = W[(size_t)(k0 + kk) * N + n0 + (lane & 31)]; }
    LDS_WAIT(); asm volatile("" ::: "memory");
    const int c = lane & 7;
#pragma unroll
    for (int j = 0; j < 4; ++j) { const int n = (lane >> 3) + 8 * j; const LAS float* s = scr + (8 * c) * 33 + n;
        v4u o; o.x = pk2(s[0 * 33], s[1 * 33]); o.y = pk2(s[2 * 33], s[3 * 33]); o.z = pk2(s[4 * 33], s[5 * 33]); o.w = pk2(s[6 * 33], s[7 * 33]);
        *(GAS v4u*)(WT + (size_t)(drow0 + n) * K + k0 + 8 * c) = o; }
    LDS_WAIT(); asm volatile("" ::: "memory");
}
DI int remap_w1(int n) { return n < 5120 ? n : (n < 5152 ? n - 5120 + C_DT : n - 32); }
DI void rms_row_bf16(const float* xrow, const float* g, bf16* orow, int lane) {
    const GAS f32x4* xr = (const GAS f32x4*)xrow + lane;
    f32x4 v[8]; float s = 0.f;
#pragma unroll
    for (int j = 0; j < 8; ++j) { v[j] = xr[64 * j]; s += (v[j].x * v[j].x + v[j].y * v[j].y) + (v[j].z * v[j].z + v[j].w * v[j].w); }
    const float rs = 1.0f / sqrtf(wave_sum(s) * (1.f / DM) + EPS);
    const GAS f32x4* gr = (const GAS f32x4*)g + lane;
    GAS v2u* o8 = (GAS v2u*)orow + lane;
#pragma unroll
    for (int j = 0; j < 8; ++j) { const f32x4 gg = gr[64 * j]; v2u o; o.x = pk2(v[j].x * rs * gg.x, v[j].y * rs * gg.y); o.y = pk2(v[j].z * rs * gg.z, v[j].w * rs * gg.w); o8[64 * j] = o; }
}
DI void rms_row_f32(const float* xrow, const float* g, float* orow, int lane) {
    const GAS f32x4* xr = (const GAS f32x4*)xrow + lane;
    f32x4 v[8]; float s = 0.f;
#pragma unroll
    for (int j = 0; j < 8; ++j) { v[j] = xr[64 * j]; s += (v[j].x * v[j].x + v[j].y * v[j].y) + (v[j].z * v[j].z + v[j].w * v[j].w); }
    const float rs = 1.0f / sqrtf(wave_sum(s) * (1.f / DM) + EPS);
    const GAS f32x4* gr = (const GAS f32x4*)g + lane;
    GAS f32x4* o = (GAS f32x4*)orow + lane;
#pragma unroll
    for (int j = 0; j < 8; ++j) { const f32x4 gg = gr[64 * j]; o[64 * j] = v[j] * rs * gg; }
}
DI void norm_phase(Frame& F, const float* HP, const float* HS, const float* g, bf16* XN) {
    const int gw = F.bid * NWAVES + F.wave, NGW = F.G * NWAVES;
    for (int m = gw; m < MROWS; m += NGW) rms_row_bf16(m < MP ? HP + (size_t)m * DM : HS + (size_t)(m - MP) * DM, g, XN + (size_t)m * DM, F.lane);
}

DI void p0_prologue(Frame& F) {
    LAS float* scr = (LAS float*)(F.lds + F.wave * 16384);
    const int gw = F.bid * NWAVES + F.wave, NGW = F.G * NWAVES, lane = F.lane;
    unsigned char* ws = F.ws;
    constexpr int I0 = 32 * 257, I1 = 64 * 64, I2 = 32 * 256, I4 = 128 * 64, I6 = 32 * 224, I7 = 32 * 64;
    constexpr int NITEMS = I0 + I1 + 2 * I2 + 2 * I4 + I6 + I7;
    for (int it = gw; it < NITEMS; it += NGW) {
        int r = it;
        if (r < I0) { const int kb = r / 257, nb = r % 257; transpose_item(F.in[10], 8224, (bf16*)(ws + WS_W1T), 2048, 64 * kb, 32 * nb, remap_w1(32 * nb), scr, lane); continue; } r -= I0;
        if (r < I1) { const int kb = r / 64, nb = r % 64; transpose_item(F.in[18], 2048, (bf16*)(ws + WS_W2T), 4096, 64 * kb, 32 * nb, 32 * nb, scr, lane); continue; } r -= I1;
        if (r < 2 * I2) { const int l = r / I2, q = r % I2, kb = q / 256, nb = q % 256; transpose_item(F.in[21] + (size_t)l * 2048 * 8192, 8192, (bf16*)(ws + WS_WM1T) + (size_t)l * 8192 * 2048, 2048, 64 * kb, 32 * nb, 32 * nb, scr, lane); continue; } r -= 2 * I2;
        if (r < 2 * I4) { const int l = r / I4, q = r % I4, kb = q / 64, nb = q % 64; transpose_item(F.in[22] + (size_t)l * 8192 * 2048, 2048, (bf16*)(ws + WS_WM2T) + (size_t)l * 2048 * 8192, 8192, 64 * kb, 32 * nb, 32 * nb, scr, lane); continue; } r -= 2 * I4;
        if (r < I6) { const int kb = r / 224, nb = r % 224; transpose_item(F.in[19], 7168, (bf16*)(ws + WS_W5T), 2048, 64 * kb, 32 * nb, 32 * nb, scr, lane); continue; } r -= I6;
        { const int kb = r / 64, nb = r % 64; transpose_item(F.in[20], 2048, (bf16*)(ws + WS_W6T), 2048, 64 * kb, 32 * nb, 32 * nb, scr, lane); }
    }
    { GAS v4u* z = (GAS v4u*)((bf16*)(ws + WS_W1T) + (size_t)8224 * 2048); const int n16 = 224 * 2048 * 2 / 16;
      for (int i = F.bid * NTHR + F.tid; i < n16; i += F.G * NTHR) z[i] = (v4u){0u, 0u, 0u, 0u}; }
    { float* rope = (float*)(ws + WS_ROPE);
      for (int i = F.bid * NTHR + F.tid; i < 8196 * 8; i += F.G * NTHR) {
          const int pos = i >> 3, k = i & 7;
          const double invf = k == 0 ? 1.0 : k == 1 ? 0.193922758102417 : k == 2 ? 0.03760603442788124 : k == 3 ? 0.007292666472494602 : k == 4 ? 0.0014142136787995696 : k == 5 ? 0.00027424818836152554 : k == 6 ? 5.318298644851893e-05 : 1.031338433676865e-05;
          const float angf = (float)pos * (float)invf;
          const double rev = (double)angf * 0.15915494309189535;
          const float fr = (float)(rev - __builtin_rint(rev));
          rope[pos * 16 + k] = __builtin_amdgcn_cosf(fr); rope[pos * 16 + 8 + k] = __builtin_amdgcn_sinf(fr);
      } }
    norm_phase(F, F.in[0], F.in[1], F.in[8], (bf16*)(ws + WS_XN));
}

constexpr int AT_KSTR = 144;
constexpr int AT_K = 0, AT_V = 256 * AT_KSTR;
template <bool SINK>
DI void attn_prompt_unit(Frame& F, const bf16* QKV, int ld, int qcol0, int kcol, int vcol, int dil, int rho, int cb, int maxd,
                         const float* sink4, bf16* O, int ldo, int ocol0, float* lse, int hq0) {
    LAS unsigned char* lds = F.lds;
    const int tid = F.tid, lane = F.lane, wave = F.wave, r = lane & 31, h = lane >> 5;
    __syncthreads();
#pragma unroll
    for (int i = 0; i < 4; ++i) {
        const int c = tid + NTHR * i, row = c >> 3, ch = c & 7;
        const int mk = 128 * (cb - 1) + row;
        v4u kv = (v4u){0u, 0u, 0u, 0u}, vv = (v4u){0u, 0u, 0u, 0u};
        if (mk >= 0) { const size_t t = (size_t)mk * dil + rho; kv = *(const GAS v4u*)(QKV + t * ld + kcol + 8 * ch); vv = *(const GAS v4u*)(QKV + t * ld + vcol + 8 * ch); }
        *(LAS v4u*)(lds + AT_K + row * AT_KSTR + ch * 16) = kv;
        *(LAS v4u*)(lds + AT_V + (ch >> 2) * 16384 + row * 64 + (ch & 3) * 16) = vv;
    }
    __syncthreads();
    const int g4 = (lane >> 4) & 1, q4 = (lane & 15) >> 2, p4 = lane & 3;
#pragma unroll 1
    for (int jb = wave; jb < 16; jb += 8) {
        const int qt = jb & 3, rep = jb >> 2;
        const int mq = 128 * cb + 32 * qt + r; const size_t tq = (size_t)mq * dil + rho;
        bf16x8 qf[4];
        { const bf16* qp = QKV + tq * ld + qcol0 + rep * 64 + 8 * h;
#pragma unroll
          for (int ks = 0; ks < 4; ++ks) qf[ks] = *(const GAS bf16x8*)(qp + 16 * ks); }
        f32x16 X[5];
#pragma unroll
        for (int kt = 0; kt < 5; ++kt) {
#pragma unroll
            for (int e = 0; e < 16; ++e) X[kt][e] = 0.f;
#pragma unroll
            for (int ks = 0; ks < 4; ++ks) {
                const bf16x8 kf = *(const LAS bf16x8*)(lds + AT_K + (32 * qt + 32 * kt + r) * AT_KSTR + (16 * ks + 8 * h) * 2);
                X[kt] = MFMA32(kf, qf[ks], X[kt]);
            }
            __builtin_amdgcn_sched_barrier(0);
        }
        const float NEG = -3.0e38f;
        float mx = NEG;
#pragma unroll
        for (int kt = 0; kt < 5; ++kt)
#pragma unroll
            for (int e = 0; e < 16; ++e) {
                const int jw = 32 * kt + crow(e, h), dist = 128 + r - jw;
                const bool ok = (dist >= 0) && (dist <= maxd) && (cb > 0 || (32 * qt + jw) >= 128);
                X[kt][e] = ok ? X[kt][e] : NEG;
                mx = fmaxf(mx, X[kt][e]);
            }
        mx = fmaxf(mx, __shfl_xor(mx, 32));
        float msc = mx * 0.125f; float sk = 0.f;
        if (SINK) { sk = sink4[rep]; msc = fmaxf(msc, sk); }
        const float c1 = 0.125f * 1.4426950408889634f, c2 = msc * 1.4426950408889634f;
        float den = 0.f;
#pragma unroll
        for (int kt = 0; kt < 5; ++kt)
#pragma unroll
            for (int e = 0; e < 16; ++e) { const float p = fexp2(X[kt][e] * c1 - c2); X[kt][e] = p; den += p; }
        den += __shfl_xor(den, 32);
        if (SINK) den += fexp2((sk - msc) * 1.4426950408889634f);
        f32x16 Oa[2];
#pragma unroll
        for (int d = 0; d < 2; ++d)
#pragma unroll
            for (int e = 0; e < 16; ++e) Oa[d][e] = 0.f;
#pragma unroll
        for (int kt = 0; kt < 5; ++kt)
#pragma unroll
            for (int s = 0; s < 2; ++s) {
                const bf16x8 pf = pack8(X[kt][8 * s], X[kt][8 * s + 1], X[kt][8 * s + 2], X[kt][8 * s + 3], X[kt][8 * s + 4], X[kt][8 * s + 5], X[kt][8 * s + 6], X[kt][8 * s + 7]);
                const int krow0 = 32 * qt + 32 * kt + 16 * s + 4 * h + q4;
#pragma unroll
                for (int d = 0; d < 2; ++d) {
                    const LAS unsigned char* vp = lds + AT_V + d * 16384 + krow0 * 64 + 32 * g4 + 8 * p4;
                    const bf16x8 vf = cat8(trr(vp), trr(vp + 8 * 64));
                    Oa[d] = MFMA32(vf, pf, Oa[d]);
                }
                __builtin_amdgcn_sched_barrier(0);
            }
        const float inv = 1.0f / den;
        bf16* op = O + tq * ldo + ocol0 + rep * 64;
#pragma unroll
        for (int d = 0; d < 2; ++d)
#pragma unroll
            for (int rq = 0; rq < 4; ++rq) {
                v2u w; w.x = pk2(Oa[d][4 * rq] * inv, Oa[d][4 * rq + 1] * inv); w.y = pk2(Oa[d][4 * rq + 2] * inv, Oa[d][4 * rq + 3] * inv);
                *(GAS v2u*)(op + 32 * d + 8 * rq + 4 * h) = w;
            }
        if (lse != nullptr && h == 0) lse[tq * 32 + hq0 + rep] = msc + __logf(den);
    }
}

DI void attn_sample_swa_unit(Frame& F, int b, int g) {
    LAS float* Ks = (LAS float*)F.lds;
    LAS float* Vs = Ks + 132 * 65;
    LAS float* Qs = Vs + 132 * 64;
    LAS float* Ps = Qs + 16 * 64;
    const int tid = F.tid;
    const bf16* P1 = (const bf16*)(F.ws + WS_P1);
    const float* ck = F.in[4] + (size_t)b * 128 * 512 + g * 64; const float* cv = F.in[5] + (size_t)b * 128 * 512 + g * 64;
    __syncthreads();
    for (int i = tid; i < 132 * 64; i += NTHR) {
        const int j = i >> 6, d = i & 63; float kk, vv;
        if (j < 128) { kk = ck[(size_t)j * 512 + d]; vv = cv[(size_t)j * 512 + d]; }
        else { const size_t row = (size_t)(MP + 4 * b + (j - 128)) * N1; kk = bflo(P1[row + C_K + g * 64 + d]); vv = bflo(P1[row + C_V + g * 64 + d]); }
        Ks[j * 65 + d] = kk; Vs[j * 64 + d] = vv;
    }
    for (int i = tid; i < 16 * 64; i += NTHR) { const int qr = i >> 6, d = i & 63, rep = qr >> 2, t = qr & 3;
        Qs[i] = bflo(P1[(size_t)(MP + 4 * b + t) * N1 + C_Q + (4 * g + rep) * 64 + d]); }
    __syncthreads();
    const int qr = tid >> 5, ln = tid & 31, rep = qr >> 2, t = qr & 3;
    float sc[5]; float mx = -3.0e38f;
#pragma unroll
    for (int i = 0; i < 5; ++i) {
        const int j = ln + 32 * i; float s = -3.0e38f;
        if (j < 132) {
            const bool ok = j < 128 ? (j > t) : ((j - 128) <= t);
            if (ok) { float a = 0.f;
#pragma unroll 16
                for (int d = 0; d < 64; ++d) a += Qs[qr * 64 + d] * Ks[j * 65 + d];
                s = a * 0.125f; }
        }
        sc[i] = s; mx = fmaxf(mx, s);
    }
#pragma unroll
    for (int o = 1; o < 32; o <<= 1) mx = fmaxf(mx, __shfl_xor(mx, o));
    const float sk = F.in[17][4 * g + rep]; mx = fmaxf(mx, sk);
    float den = 0.f;
#pragma unroll
    for (int i = 0; i < 5; ++i) { const float p = sc[i] > -1.0e38f ? fexp(sc[i] - mx) : 0.f; sc[i] = p; den += p; }
#pragma unroll
    for (int o = 1; o < 32; o <<= 1) den += __shfl_xor(den, o);
    den += fexp(sk - mx);
    const float inv = 1.0f / den;
#pragma unroll
    for (int i = 0; i < 5; ++i) { const int j = ln + 32 * i; if (j < 132) Ps[qr * 136 + j] = sc[i] * inv; }
    __syncthreads();
    float o0 = 0.f, o1 = 0.f;
    for (int j = 0; j < 132; ++j) { const float p = Ps[qr * 136 + j]; o0 += p * Vs[j * 64 + 2 * ln]; o1 += p * Vs[j * 64 + 2 * ln + 1]; }
    bf16* MIX = (bf16*)(F.ws + WS_MIX);
    *(GAS unsigned*)(MIX + (size_t)(MP + 4 * b + t) * KMIX + 2048 + (4 * g + rep) * 64 + 2 * ln) = pk2(o0, o1);
}

DI void attn_sample_dil_unit(Frame& F, int b, int g) {
    LAS float* Ks = (LAS float*)F.lds;
    LAS float* Vs = Ks + 129 * 65;
    LAS float* Qs = Vs + 129 * 64;
    LAS float* Ps = Qs + 4 * 64;
    LAS float* Red = Ps + 4 * 132;
    LAS float* Ob = Red + 16;
    LAS float* Lb = Ob + 3 * 16 * 64;
    const int tid = F.tid, wave = F.wave, lane = F.lane;
    const bf16* P5 = (const bf16*)(F.ws + WS_P5);
    const float* ck = F.in[6] + (size_t)b * 2048 * 512 + g * 64; const float* cv = F.in[7] + (size_t)b * 2048 * 512 + g * 64;
#pragma unroll 1
    for (int pat = 0; pat < 3; ++pat) {
        const int dil = pat == 0 ? 1 : (pat == 1 ? 4 : 16);
#pragma unroll 1
        for (int t = 0; t < 4; ++t) {
            __syncthreads();
            for (int i = tid; i < 129 * 64; i += NTHR) {
                const int k = i >> 6, d = i & 63; const int j = 2048 + t - dil * k; float kk, vv;
                if (j < 2048) { kk = ck[(size_t)j * 512 + d]; vv = cv[(size_t)j * 512 + d]; }
                else { const size_t row = (size_t)(MP + 4 * b + (j - 2048)) * N5; kk = bflo(P5[row + O_K + g * 64 + d]); vv = bflo(P5[row + O_V + g * 64 + d]); }
                Ks[k * 65 + d] = kk; Vs[k * 64 + d] = vv;
            }
            if (tid < 256) { const int rep = tid >> 6, d = tid & 63; Qs[tid] = bflo(P5[(size_t)(MP + 4 * b + t) * N5 + pat * 2048 + (4 * g + rep) * 64 + d]); }
            __syncthreads();
            const int rep = tid >> 7, ln = tid & 127;
            float s0 = -3.0e38f, s1 = -3.0e38f;
            { float a = 0.f;
#pragma unroll 16
              for (int d = 0; d < 64; ++d) a += Qs[rep * 64 + d] * Ks[ln * 65 + d];
              s0 = a * 0.125f; }
            if (ln == 0) { float a = 0.f;
              for (int d = 0; d < 64; ++d) a += Qs[rep * 64 + d] * Ks[128 * 65 + d];
              s1 = a * 0.125f; }
            float mx = fmaxf(s0, s1);
#pragma unroll
            for (int o = 1; o < 64; o <<= 1) mx = fmaxf(mx, __shfl_xor(mx, o));
            if (lane == 0) Red[wave] = mx;
            __syncthreads();
            mx = fmaxf(Red[2 * rep], Red[2 * rep + 1]);
            const float p0 = fexp(s0 - mx), p1 = (ln == 0) ? fexp(s1 - mx) : 0.f;
            float den = p0 + p1;
#pragma unroll
            for (int o = 1; o < 64; o <<= 1) den += __shfl_xor(den, o);
            Ps[rep * 132 + ln] = p0; if (ln == 0) Ps[rep * 132 + 128] = p1;
            __syncthreads();
            if (lane == 0) Red[wave] = den;
            __syncthreads();
            den = Red[2 * rep] + Red[2 * rep + 1];
            if (tid < 256) { const int rp = tid >> 6, d = tid & 63; float o = 0.f;
                for (int k = 0; k < 129; ++k) o += Ps[rp * 132 + k] * Vs[k * 64 + d];
                const float dn = Red[2 * rp] + Red[2 * rp + 1];
                Ob[((pat * 4 + t) * 4 + rp) * 64 + d] = o / dn; }
            if (ln == 0) Lb[(pat * 4 + t) * 4 + rep] = mx + __logf(den);
        }
    }
    __syncthreads();
    bf16* MRG = (bf16*)(F.ws + WS_MRG);
    for (int i = tid; i < 16 * 64; i += NTHR) {
        const int d = i & 63, rep = (i >> 6) & 3, t = i >> 8;
        const float l0 = Lb[(0 * 4 + t) * 4 + rep], l1 = Lb[(1 * 4 + t) * 4 + rep], l2 = Lb[(2 * 4 + t) * 4 + rep];
        const float lm = fmaxf(l0, fmaxf(l1, l2)); const float w0 = fexp(l0 - lm), w1 = fexp(l1 - lm), w2 = fexp(l2 - lm);
        const float o = (w0 * Ob[((0 * 4 + t) * 4 + rep) * 64 + d] + w1 * Ob[((1 * 4 + t) * 4 + rep) * 64 + d] + w2 * Ob[((2 * 4 + t) * 4 + rep) * 64 + d]) / (w0 + w1 + w2);
        MRG[(size_t)(MP + 4 * b + t) * DM + (4 * g + rep) * 64 + d] = (bf16)(pk2(o, 0.f) & 0xffffu);
    }
}

DI void ssd_dt_scan(Frame& F, int t0, int head, float& dt0, float& dt1, float& acs0, float& acs1, float& total) {
    const float* DT = (const float*)(F.ws + WS_DT);
    const float bias = F.in[13][head], a = -__expf(F.in[14][head]);
    const int l = 2 * F.lane;
    dt0 = softplusf_(DT[(size_t)(t0 + l) * 32 + head] + bias); dt1 = softplusf_(DT[(size_t)(t0 + l + 1) * 32 + head] + bias);
    const float la0 = dt0 * a, la1 = dt1 * a;
    float s = la0 + la1;
#pragma unroll
    for (int o = 1; o < 64; o <<= 1) { const float v = __shfl_up(s, o); if (F.lane >= o) s += v; }
    acs1 = s; acs0 = s - la1; total = __shfl(s, 63);
}

template <class Sink>
DI void conv_task(Frame& F, int t0, int l0, int chabs, const Sink& sink) {
    const bf16* P1 = (const bf16*)(F.ws + WS_P1);
    const float* cw = F.in[11]; const float* cbias = F.in[12];
    float w[4][8], bs[8];
#pragma unroll
    for (int i = 0; i < 4; ++i) { const f32x4 a = *(const f32x4*)(cw + i * CONVD + chabs), b = *(const f32x4*)(cw + i * CONVD + chabs + 4);
        w[i][0] = a[0]; w[i][1] = a[1]; w[i][2] = a[2]; w[i][3] = a[3]; w[i][4] = b[0]; w[i][5] = b[1]; w[i][6] = b[2]; w[i][7] = b[3]; }
    { const f32x4 a = *(const f32x4*)(cbias + chabs), b = *(const f32x4*)(cbias + chabs + 4); bs[0] = a[0]; bs[1] = a[1]; bs[2] = a[2]; bs[3] = a[3]; bs[4] = b[0]; bs[5] = b[1]; bs[6] = b[2]; bs[7] = b[3]; }
    float hst[3][8];
#pragma unroll
    for (int i = 0; i < 3; ++i) {
        const int t = t0 + l0 - 3 + i; v4u u = (v4u){0u, 0u, 0u, 0u};
        if (t >= 0) u = *(const GAS v4u*)(P1 + (size_t)t * N1 + C_XBC + chabs);
        hst[i][0] = bflo(u.x); hst[i][1] = bfhi(u.x); hst[i][2] = bflo(u.y); hst[i][3] = bfhi(u.y); hst[i][4] = bflo(u.z); hst[i][5] = bfhi(u.z); hst[i][6] = bflo(u.w); hst[i][7] = bfhi(u.w);
    }
#pragma unroll
    for (int i = 0; i < 16; ++i) {
        const v4u u = *(const GAS v4u*)(P1 + (size_t)(t0 + l0 + i) * N1 + C_XBC + chabs);
        float cur[8] = {bflo(u.x), bfhi(u.x), bflo(u.y), bfhi(u.y), bflo(u.z), bfhi(u.z), bflo(u.w), bfhi(u.w)};
        float o[8];
#pragma unroll
        for (int j = 0; j < 8; ++j) { const float a = bs[j] + w[0][j] * hst[0][j] + w[1][j] * hst[1][j] + w[2][j] * hst[2][j] + w[3][j] * cur[j]; o[j] = siluf_(a);
            hst[0][j] = hst[1][j]; hst[1][j] = hst[2][j]; hst[2][j] = cur[j]; }
        sink(l0 + i, o);
    }
}

constexpr int SA_W = 0, SA_B = 8192, SA_BSTR = 320, SA_X = SA_B + 128 * SA_BSTR, SA_XSTR = 576;
DI void ssd_a_unit(Frame& F, int c, int g) {
    LAS unsigned char* lds = F.lds;
    LAS float* Wl = (LAS float*)(lds + SA_W);
    const int tid = F.tid, lane = F.lane, wave = F.wave, r = lane & 31, h = lane >> 5, t0 = 128 * c;
    bf16* XC = (bf16*)(F.ws + WS_XC); float* ST = (float*)(F.ws + WS_ST); float* CD = (float*)(F.ws + WS_CD);
    __syncthreads();
    { float dt0, dt1, a0, a1, tot; ssd_dt_scan(F, t0, 8 * g + wave, dt0, dt1, a0, a1, tot);
      Wl[wave * 128 + 2 * lane] = dt0 * __expf(tot - a0); Wl[wave * 128 + 2 * lane + 1] = dt1 * __expf(tot - a1);
      if (lane == 63) CD[c * 32 + 8 * g + wave] = __expf(tot); }
    __syncthreads();
    const int g4 = (lane >> 4) & 1, q4 = (lane & 15) >> 2, p4 = lane & 3;
#pragma unroll 1
    for (int half = 0; half < 2; ++half) {
        if (half == 0 || tid < 256) {
            int oct, run; if (half == 0) { oct = tid & 63; run = tid >> 6; } else { oct = 32 + (tid & 31); run = tid >> 5; }
            int chabs, kind, lcol, hh = 0;
            if (oct < 16) { kind = 0; chabs = 2048 + 128 * g + 8 * oct; lcol = 8 * oct; }
            else if (oct < 32) { kind = 1; chabs = 2560 + 128 * g + 8 * (oct - 16); lcol = 0; }
            else { kind = 2; const int idx = oct - 32, hl = idx >> 3; hh = 4 * half + hl; chabs = 512 * g + 64 * hh + 8 * (idx & 7); lcol = 64 * hl + 8 * (idx & 7); }
            conv_task(F, t0, 16 * run, chabs, [&](int l, const float (&o)[8]) {
                v4u pkd; pkd.x = pk2(o[0], o[1]); pkd.y = pk2(o[2], o[3]); pkd.z = pk2(o[4], o[5]); pkd.w = pk2(o[6], o[7]);
                *(GAS v4u*)(XC + (size_t)(t0 + l) * CONVD + chabs) = pkd;
                if (kind == 0) *(LAS v4u*)(lds + SA_B + l * SA_BSTR + lcol * 2) = pkd;
                else if (kind == 2) { const float wv = Wl[hh * 128 + l]; v4u s; s.x = pk2(o[0] * wv, o[1] * wv); s.y = pk2(o[2] * wv, o[3] * wv); s.z = pk2(o[4] * wv, o[5] * wv); s.w = pk2(o[6] * wv, o[7] * wv);
                    *(LAS v4u*)(lds + SA_X + l * SA_XSTR + lcol * 2) = s; }
            });
        }
        __syncthreads();
        { const int hl = wave >> 1, pt = wave & 1, head = 8 * g + 4 * half + hl;
          f32x16 acc[4];
#pragma unroll
          for (int nt = 0; nt < 4; ++nt)
#pragma unroll
              for (int e = 0; e < 16; ++e) acc[nt][e] = 0.f;
#pragma unroll
          for (int ks = 0; ks < 8; ++ks) {
              const int lrow = 16 * ks + 8 * h + q4;
              const LAS unsigned char* ap = lds + SA_X + lrow * SA_XSTR + (64 * hl + 32 * pt + 16 * g4 + 4 * p4) * 2;
              const bf16x8 af = cat8(trr(ap), trr(ap + 4 * SA_XSTR));
#pragma unroll
              for (int nt = 0; nt < 4; ++nt) {
                  const LAS unsigned char* bp = lds + SA_B + lrow * SA_BSTR + (32 * nt + 16 * g4 + 4 * p4) * 2;
                  const bf16x8 bfr = cat8(trr(bp), trr(bp + 4 * SA_BSTR));
                  acc[nt] = MFMA32(af, bfr, acc[nt]);
              }
          }
          float* sp = ST + ((size_t)(c * 32 + head) * 64) * 128;
#pragma unroll
          for (int nt = 0; nt < 4; ++nt)
#pragma unroll
              for (int e = 0; e < 16; ++e) sp[(size_t)(32 * pt + crow(e, h)) * 128 + 32 * nt + r] = acc[nt][e];
        }
        __syncthreads();
    }
}

DI void ssd_carry_phase(Frame& F) {
    const float* ST = (const float*)(F.ws + WS_ST); const float* CD = (const float*)(F.ws + WS_CD); bf16* HIN = (bf16*)(F.ws + WS_HIN);
    for (int gt = F.bid * NTHR + F.tid; gt < 131072; gt += F.G * NTHR) {
        const int e = 2 * gt, head = e >> 13;
        f32x2 hs = {0.f, 0.f};
#pragma unroll 1
        for (int c0 = 0; c0 < 64; c0 += 16) {
            f32x2 s[16]; float dc[16];
#pragma unroll
            for (int i = 0; i < 16; ++i) { s[i] = *(const GAS f32x2*)(ST + (size_t)(c0 + i) * 262144 + e); dc[i] = CD[(c0 + i) * 32 + head]; }
#pragma unroll
            for (int i = 0; i < 16; ++i) { *(GAS unsigned*)(HIN + (size_t)(c0 + i) * 262144 + e) = pk2(hs.x, hs.y); hs = hs * dc[i] + s[i]; }
        }
        *(GAS f32x2*)(F.out + OUT_PSSM + e) = hs;
    }
}

constexpr int SC_ACS = 0, SC_DT = 4096, SC_B = 8192, SC_STR = 272, SC_C = SC_B + 128 * SC_STR, SC_X = SC_C + 128 * SC_STR, SC_XSTR = 192, SC_H = SC_X + 128 * SC_XSTR, SC_SSQ = SC_H + 64 * SC_STR;
DI void ssd_c_unit(Frame& F, int c, int g) {
    LAS unsigned char* lds = F.lds;
    LAS float* ACS = (LAS float*)(lds + SC_ACS); LAS float* DTV = (LAS float*)(lds + SC_DT); LAS float* SSQ = (LAS float*)(lds + SC_SSQ);
    const int tid = F.tid, lane = F.lane, wave = F.wave, r = lane & 31, h = lane >> 5, t0 = 128 * c;
    const bf16* XC = (const bf16*)(F.ws + WS_XC); const bf16* HIN = (const bf16*)(F.ws + WS_HIN); const bf16* P1 = (const bf16*)(F.ws + WS_P1); bf16* MIX = (bf16*)(F.ws + WS_MIX);
    __syncthreads();
    { float dt0, dt1, a0, a1, tot; ssd_dt_scan(F, t0, 8 * g + wave, dt0, dt1, a0, a1, tot);
      ACS[wave * 128 + 2 * lane] = a0; ACS[wave * 128 + 2 * lane + 1] = a1; DTV[wave * 128 + 2 * lane] = dt0; DTV[wave * 128 + 2 * lane + 1] = dt1; }
#pragma unroll
    for (int i = 0; i < 4; ++i) { const int cc = tid + NTHR * i, row = cc >> 4, ch = cc & 15;
        *(LAS v4u*)(lds + SC_B + row * SC_STR + ch * 16) = *(const GAS v4u*)(XC + (size_t)(t0 + row) * CONVD + 2048 + 128 * g + 8 * ch);
        *(LAS v4u*)(lds + SC_C + row * SC_STR + ch * 16) = *(const GAS v4u*)(XC + (size_t)(t0 + row) * CONVD + 2560 + 128 * g + 8 * ch); }
    __syncthreads();
    const int lt = wave >> 1, pt = wave & 1, l = 32 * lt + r;
    const int g4 = (lane >> 4) & 1, q4 = (lane & 15) >> 2, p4 = lane & 3;
    const LAS unsigned char* cfp = lds + SC_C + l * SC_STR + 16 * h;
    unsigned Xp[4][8];
#pragma unroll
    for (int st = 0; st < 4; ++st) {
#pragma unroll
        for (int e = 0; e < 8; ++e) Xp[st][e] = 0u;
        if (st <= lt) {
            f32x16 X;
#pragma unroll
            for (int e = 0; e < 16; ++e) X[e] = 0.f;
#pragma unroll
            for (int ks = 0; ks < 8; ++ks) { const bf16x8 bfr = *(const LAS bf16x8*)(lds + SC_B + (32 * st + r) * SC_STR + (16 * ks + 8 * h) * 2); const bf16x8 cf = *(const LAS bf16x8*)(cfp + 32 * ks); X = MFMA32(bfr, cf, X); }
#pragma unroll
            for (int e = 0; e < 8; ++e) Xp[st][e] = pk2(X[2 * e], X[2 * e + 1]);
        }
    }
    float ssq = 0.f;
    bf16* myrow = MIX + (size_t)(t0 + l) * KMIX + 512 * g + 32 * pt + 4 * h;
#pragma unroll 1
    for (int hh = 0; hh < 8; ++hh) {
        const int head = 8 * g + hh;
        __syncthreads();
#pragma unroll
        for (int i = 0; i < 2; ++i) { const int cc = tid + NTHR * i;
            { const int row = cc >> 3, ch = cc & 7; *(LAS v4u*)(lds + SC_X + row * SC_XSTR + ch * 16) = *(const GAS v4u*)(XC + (size_t)(t0 + row) * CONVD + 512 * g + 64 * hh + 8 * ch); }
            { const int row = cc >> 4, ch = cc & 15; *(LAS v4u*)(lds + SC_H + row * SC_STR + ch * 16) = *(const GAS v4u*)(HIN + ((size_t)(c * 32 + head) * 64 + row) * 128 + 8 * ch); } }
        __syncthreads();
        f32x16 acc;
#pragma unroll
        for (int e = 0; e < 16; ++e) acc[e] = 0.f;
#pragma unroll
        for (int ks = 0; ks < 8; ++ks) { const bf16x8 hf = *(const LAS bf16x8*)(lds + SC_H + (32 * pt + r) * SC_STR + (16 * ks + 8 * h) * 2); const bf16x8 cf = *(const LAS bf16x8*)(cfp + 32 * ks); acc = MFMA32(hf, cf, acc); }
        const float al = ACS[hh * 128 + l], el = __expf(al);
#pragma unroll
        for (int e = 0; e < 16; ++e) acc[e] *= el;
#pragma unroll
        for (int st = 0; st < 4; ++st) {
            if (st <= lt) {
#pragma unroll
                for (int ss = 0; ss < 2; ++ss) {
                    float mv[8];
#pragma unroll
                    for (int j = 0; j < 8; ++j) {
                        const int e = 8 * ss + j, sl = crow(e, h), s = 32 * st + sl;
                        const float cb = (e & 1) ? bfhi(Xp[st][e >> 1]) : bflo(Xp[st][e >> 1]);
                        const float dec = __expf(al - ACS[hh * 128 + s]) * DTV[hh * 128 + s];
                        mv[j] = (st < lt || sl <= r) ? cb * dec : 0.f;
                    }
                    const bf16x8 mf = pack8(mv[0], mv[1], mv[2], mv[3], mv[4], mv[5], mv[6], mv[7]);
                    const LAS unsigned char* xp = lds + SC_X + (32 * st + 16 * ss + 4 * h + q4) * SC_XSTR + (32 * pt + 16 * g4 + 4 * p4) * 2;
                    const bf16x8 xf = cat8(trr(xp), trr(xp + 8 * SC_XSTR));
                    acc = MFMA32(xf, mf, acc);
                }
            }
        }
        const float dsk = F.in[15][head];
#pragma unroll
        for (int rq = 0; rq < 4; ++rq) {
            const int p0 = 32 * pt + 8 * rq + 4 * h;
            const v2u xx = *(const LAS v2u*)(lds + SC_X + l * SC_XSTR + p0 * 2);
            const v2u zz = *(const GAS v2u*)(P1 + (size_t)(t0 + l) * N1 + C_Z + 512 * g + 64 * hh + p0);
            const float xv[4] = {bflo(xx.x), bfhi(xx.x), bflo(xx.y), bfhi(xx.y)}, zv[4] = {bflo(zz.x), bfhi(zz.x), bflo(zz.y), bfhi(zz.y)};
            float y[4];
#pragma unroll
            for (int e = 0; e < 4; ++e) { y[e] = (acc[4 * rq + e] + dsk * xv[e]) * siluf_(zv[e]); ssq += y[e] * y[e]; }
            v2u w; w.x = pk2(y[0], y[1]); w.y = pk2(y[2], y[3]);
            *(GAS v2u*)(myrow + 64 * hh + 8 * rq) = w;
        }
    }
    ssq += __shfl_xor(ssq, 32);
    if (h == 0) SSQ[pt * 128 + l] = ssq;
    asm volatile("s_waitcnt vmcnt(0)" ::: "memory");
    __syncthreads();
    const float rstd = 1.0f / sqrtf((SSQ[l] + SSQ[128 + l]) * (1.f / 512.f) + EPS);
    const float* gn = F.in[16] + 512 * g + 32 * pt + 4 * h;
#pragma unroll 1
    for (int hh = 0; hh < 8; ++hh)
#pragma unroll
        for (int rq = 0; rq < 4; ++rq) {
            const f32x4 gg = *(const f32x4*)(gn + 64 * hh + 8 * rq);
            const v2u yy = __builtin_nontemporal_load((const GAS v2u*)(myrow + 64 * hh + 8 * rq));
            v2u w; w.x = pk2(bflo(yy.x) * rstd * gg[0], bfhi(yy.x) * rstd * gg[1]); w.y = pk2(bflo(yy.y) * rstd * gg[2], bfhi(yy.y) * rstd * gg[3]);
            *(GAS v2u*)(myrow + 64 * hh + 8 * rq) = w;
        }
}

DI void ssd_sample_unit(Frame& F, int b, int g) {
    LAS float* xc = (LAS float*)F.lds;
    LAS float* dtv = xc + 4 * 768;
    LAS float* dav = dtv + 32;
    LAS float* ys = dav + 32;
    LAS float* rs = ys + 4 * 512;
    const int tid = F.tid, lane = F.lane, wave = F.wave;
    const bf16* P1 = (const bf16*)(F.ws + WS_P1); const float* DT = (const float*)(F.ws + WS_DT); bf16* MIX = (bf16*)(F.ws + WS_MIX);
    const size_t row0 = (size_t)MP + 4 * b;
    __syncthreads();
    for (int ch = tid; ch < 768; ch += NTHR) {
        const int chabs = ch < 512 ? 512 * g + ch : (ch < 640 ? 2048 + 128 * g + (ch - 512) : 2560 + 128 * g + (ch - 640));
        float xp[7];
#pragma unroll
        for (int i = 0; i < 3; ++i) xp[i] = F.in[2][((size_t)b * 3 + i) * CONVD + chabs];
#pragma unroll
        for (int t = 0; t < 4; ++t) xp[3 + t] = bflo(P1[(row0 + t) * N1 + C_XBC + chabs]);
        const float w0 = F.in[11][chabs], w1 = F.in[11][CONVD + chabs], w2 = F.in[11][2 * CONVD + chabs], w3 = F.in[11][3 * CONVD + chabs], bb = F.in[12][chabs];
#pragma unroll
        for (int t = 0; t < 4; ++t) xc[t * 768 + ch] = siluf_(bb + w0 * xp[t] + w1 * xp[t + 1] + w2 * xp[t + 2] + w3 * xp[t + 3]);
    }
    if (tid < 32) { const int t = tid >> 3, hh = tid & 7, head = 8 * g + hh;
        const float dt = softplusf_(DT[(row0 + t) * 32 + head] + F.in[13][head]); dtv[tid] = dt; dav[tid] = __expf(dt * -__expf(F.in[14][head])); }
    __syncthreads();
    const int p = tid >> 3, ns = (tid & 7) * 16;
#pragma unroll 1
    for (int hh = 0; hh < 8; ++hh) {
        const int head = 8 * g + hh;
        const float* hp = F.in[3] + (((size_t)b * 32 + head) * 64 + p) * 128 + ns;
        float hv[16];
#pragma unroll
        for (int i = 0; i < 4; ++i) { const f32x4 v = *(const GAS f32x4*)(hp + 4 * i); hv[4 * i] = v[0]; hv[4 * i + 1] = v[1]; hv[4 * i + 2] = v[2]; hv[4 * i + 3] = v[3]; }
        const float dsk = F.in[15][head];
#pragma unroll
        for (int t = 0; t < 4; ++t) {
            const float da = dav[t * 8 + hh], xv = xc[t * 768 + 64 * hh + p], coef = dtv[t * 8 + hh] * xv;
            float part = 0.f;
#pragma unroll
            for (int i = 0; i < 16; ++i) { hv[i] = hv[i] * da + coef * xc[t * 768 + 512 + ns + i]; part += hv[i] * xc[t * 768 + 640 + ns + i]; }
            part += __shfl_xor(part, 1); part += __shfl_xor(part, 2); part += __shfl_xor(part, 4);
            if ((tid & 7) == 0) { const float z = bflo(P1[(row0 + t) * N1 + C_Z + 512 * g + 64 * hh + p]); ys[t * 512 + 64 * hh + p] = (part + dsk * xv) * siluf_(z); }
        }
        float* op = F.out + OUT_SSSM + (((size_t)b * 32 + head) * 64 + p) * 128 + ns;
#pragma unroll
        for (int i = 0; i < 4; ++i) *(GAS f32x4*)(op + 4 * i) = (f32x4){hv[4 * i], hv[4 * i + 1], hv[4 * i + 2], hv[4 * i + 3]};
    }
    __syncthreads();
    if (wave < 4) { float s = 0.f;
#pragma unroll
        for (int i = 0; i < 8; ++i) { const float v = ys[wave * 512 + lane + 64 * i]; s += v * v; }
        s = wave_sum(s); if (lane == 0) rs[wave] = 1.0f / sqrtf(s * (1.f / 512.f) + EPS); }
    __syncthreads();
    for (int i = tid; i < 4 * 256; i += NTHR) { const int t = i >> 8, cp = (i & 255) * 2; const float rr = rs[t];
        *(GAS unsigned*)(MIX + (row0 + t) * KMIX + 512 * g + cp) = pk2(ys[t * 512 + cp] * rr * F.in[16][512 * g + cp], ys[t * 512 + cp + 1] * rr * F.in[16][512 * g + cp + 1]); }
}

DI void merge_phase(Frame& F) {
    const bf16* O3 = (const bf16*)(F.ws + WS_O3); const float* LSE = (const float*)(F.ws + WS_LSE); bf16* MRG = (bf16*)(F.ws + WS_MRG);
    for (int i = F.bid * NTHR + F.tid; i < MP * 32 * 8; i += F.G * NTHR) {
        const int d8 = i & 7, hq = (i >> 3) & 31, t = i >> 8;
        const float l0 = LSE[(size_t)t * 32 + hq], l1 = LSE[(size_t)MROWS * 32 + (size_t)t * 32 + hq], l2 = LSE[(size_t)2 * MROWS * 32 + (size_t)t * 32 + hq];
        const float lm = fmaxf(l0, fmaxf(l1, l2)); float w0 = fexp(l0 - lm), w1 = fexp(l1 - lm), w2 = fexp(l2 - lm);
        const float inv = 1.0f / (w0 + w1 + w2); w0 *= inv; w1 *= inv; w2 *= inv;
        const size_t off = (size_t)t * DM + hq * 64 + d8 * 8;
        const v4u a = *(const GAS v4u*)(O3 + off), b = *(const GAS v4u*)(O3 + (size_t)MROWS * DM + off), c = *(const GAS v4u*)(O3 + (size_t)2 * MROWS * DM + off);
        v4u o;
        o.x = pk2(w0 * bflo(a.x) + w1 * bflo(b.x) + w2 * bflo(c.x), w0 * bfhi(a.x) + w1 * bfhi(b.x) + w2 * bfhi(c.x));
        o.y = pk2(w0 * bflo(a.y) + w1 * bflo(b.y) + w2 * bflo(c.y), w0 * bfhi(a.y) + w1 * bfhi(b.y) + w2 * bfhi(c.y));
        o.z = pk2(w0 * bflo(a.z) + w1 * bflo(b.z) + w2 * bflo(c.z), w0 * bfhi(a.z) + w1 * bfhi(b.z) + w2 * bfhi(c.z));
        o.w = pk2(w0 * bflo(a.w) + w1 * bflo(b.w) + w2 * bflo(c.w), w0 * bfhi(a.w) + w1 * bfhi(b.w) + w2 * bfhi(c.w));
        *(GAS v4u*)(MRG + off) = o;
    }
}

struct Args { const float* in[24]; float* out; unsigned char* ws; int ph_lo, ph_hi; };
__global__ void __launch_bounds__(NTHR, 2) mega_fwd(Args args) {
    extern __shared__ __attribute__((aligned(16))) unsigned char lds_raw[];
    Frame F;
    F.lds = (LAS unsigned char*)lds_raw;
    F.tid = threadIdx.x; F.lane = F.tid & 63; F.wave = __builtin_amdgcn_readfirstlane(F.tid >> 6);
    F.G = gridDim.x; F.bid = blockIdx.x;
    F.in = args.in;
    F.out = args.out; F.ws = args.ws;
    volatile LAS unsigned* MISC = (volatile LAS unsigned*)(F.lds + MISC_OFF);
    if (F.tid < 64) MISC[F.tid] = 0u;
    __syncthreads();
    gu32* ctl = (gu32*)(F.ws + WS_CTL);
#if MK_ONE_LAUNCH
    XcdBarrier bar = xcd_barrier_post((unsigned*)(ctl + CW_BAR), MISC + 8);
#define GRID_BAR() xcd_barrier(bar)
#else
#define GRID_BAR() do { } while (0)
#endif
    const int lo = args.ph_lo, hi = args.ph_hi;
#ifndef PH_MASK
#define PH_MASK 0x3ffff
#endif
#define IN(k) ((((PH_MASK) >> (k)) & 1) && lo <= (k) && (k) < hi)
#define SEAM(k) do { if (IN(k) && IN((k) + 1)) GRID_BAR(); } while (0)
    unsigned char* ws = F.ws;
    bf16* XN = (bf16*)(ws + WS_XN); bf16* P1 = (bf16*)(ws + WS_P1); bf16* MIX = (bf16*)(ws + WS_MIX); float* H = (float*)(ws + WS_H); bf16* U = (bf16*)(ws + WS_U);
    bf16* P5 = (bf16*)(ws + WS_P5); bf16* O3 = (bf16*)(ws + WS_O3); bf16* MRG = (bf16*)(ws + WS_MRG); float* LSE = (float*)(ws + WS_LSE);
    const float* rope = (const float*)(ws + WS_ROPE);
    using pg8::Gemm; using pg8::StaticOrder;

    if (IN(0)) { p0_prologue(F); } SEAM(0);
    if (IN(1)) { Gemm g{XN, (const bf16*)(ws + WS_W1T), MROWS, N1, DM}; StaticOrder S; S.init(MROWS, N1, F.G, F.bid);
        pg8::EpiProj1 E{P1, (float*)(ws + WS_DT), rope, F.out};
        pg8::gemm_phase<pg8::EpiProj1, StaticOrder, true, true>(F.lds, g, S, E); } SEAM(1);
    if (IN(2)) {
        for (int u = F.bid; u < 256; u += F.G) ssd_a_unit(F, u >> 2, u & 3);
        for (int u = F.bid; u < 512; u += F.G) { const int qb = u >> 3, g = u & 7;
            attn_prompt_unit<true>(F, P1, N1, C_Q + g * 256, C_K + g * 64, C_V + g * 64, 1, 0, qb, 127, F.in[17] + 4 * g, MIX, KMIX, 2048 + g * 256, nullptr, 0); }
        for (int u = F.bid; u < 512; u += F.G) ssd_sample_unit(F, u >> 2, u & 3);
        for (int u = F.bid; u < 1024; u += F.G) attn_sample_swa_unit(F, u >> 3, u & 7);
    } SEAM(2);
    if (IN(3)) { ssd_carry_phase(F); } SEAM(3);
    if (IN(4)) { for (int u = F.bid; u < 256; u += F.G) ssd_c_unit(F, u >> 2, u & 3); } SEAM(4);
    if (IN(5)) { __syncthreads(); Gemm g{MIX, (const bf16*)(ws + WS_W2T), MROWS, DM, KMIX}; StaticOrder S; S.init(MROWS, DM, F.G, F.bid);
        pg8::EpiRes E{F.in[0], F.in[1], H};
        pg8::gemm_phase<pg8::EpiRes, StaticOrder, true, true>(F.lds, g, S, E); } SEAM(5);
    if (IN(6)) { norm_phase(F, H, H + (size_t)MP * DM, F.in[9], XN); } SEAM(6);
    if (IN(7)) { Gemm g{XN, (const bf16*)(ws + WS_WM1T), MROWS, FF, DM}; StaticOrder S; S.init(MROWS, FF, F.G, F.bid);
        pg8::EpiSq E{U};
        pg8::gemm_phase<pg8::EpiSq, StaticOrder, true, true>(F.lds, g, S, E); } SEAM(7);
    if (IN(8)) { Gemm g{U, (const bf16*)(ws + WS_WM2T), MROWS, DM, FF}; StaticOrder S; S.init(MROWS, DM, F.G, F.bid);
        pg8::EpiRes E{H, H + (size_t)MP * DM, H};
        pg8::gemm_phase<pg8::EpiRes, StaticOrder, true, true>(F.lds, g, S, E); } SEAM(8);
    if (IN(9)) { norm_phase(F, H, H + (size_t)MP * DM, F.in[8] + DM, XN); } SEAM(9);
    if (IN(10)) { Gemm g{XN, (const bf16*)(ws + WS_W5T), MROWS, N5, DM}; StaticOrder S; S.init(MROWS, N5, F.G, F.bid);
        pg8::EpiProj5 E{P5, rope, F.out};
        pg8::gemm_phase<pg8::EpiProj5, StaticOrder, true, true>(F.lds, g, S, E); } SEAM(10);
    if (IN(11)) {
        for (int u = F.bid; u < 1536; u += F.G) { const int pat = u >> 9, v = u & 511, blk = v >> 3, g = v & 7;
            const int dil = pat == 0 ? 1 : (pat == 1 ? 4 : 16), nb = 64 / dil, rho = blk / nb, cb = blk % nb;
            attn_prompt_unit<false>(F, P5, N5, pat * 2048 + g * 256, O_K + g * 64, O_V + g * 64, dil, rho, cb, 128, nullptr, O3 + (size_t)pat * MROWS * DM, DM, g * 256, LSE + (size_t)pat * MROWS * 32, 4 * g); }
        for (int u = F.bid; u < 1024; u += F.G) attn_sample_dil_unit(F, u >> 3, u & 7);
    } SEAM(11);
    if (IN(12)) { merge_phase(F); } SEAM(12);
    if (IN(13)) { __syncthreads(); Gemm g{MRG, (const bf16*)(ws + WS_W6T), MROWS, DM, DM}; StaticOrder S; S.init(MROWS, DM, F.G, F.bid);
        pg8::EpiRes E{H, H + (size_t)MP * DM, H};
        pg8::gemm_phase<pg8::EpiRes, StaticOrder, true, true>(F.lds, g, S, E); } SEAM(13);
    if (IN(14)) { norm_phase(F, H, H + (size_t)MP * DM, F.in[9] + DM, XN); } SEAM(14);
    if (IN(15)) { Gemm g{XN, (const bf16*)(ws + WS_WM1T) + (size_t)FF * DM, MROWS, FF, DM}; StaticOrder S; S.init(MROWS, FF, F.G, F.bid);
        pg8::EpiSq E{U};
        pg8::gemm_phase<pg8::EpiSq, StaticOrder, true, true>(F.lds, g, S, E); } SEAM(15);
    if (IN(16)) { Gemm g{U, (const bf16*)(ws + WS_WM2T) + (size_t)FF * DM, MROWS, DM, FF}; StaticOrder S; S.init(MROWS, DM, F.G, F.bid);
        pg8::EpiRes E{H, H + (size_t)MP * DM, H};
        pg8::gemm_phase<pg8::EpiRes, StaticOrder, true, true>(F.lds, g, S, E); } SEAM(16);
    if (IN(17)) { const int gw = F.bid * NWAVES + F.wave, NGW = F.G * NWAVES;
        for (int m = gw; m < MROWS; m += NGW) rms_row_f32(H + (size_t)m * DM, F.in[23], F.out + (size_t)m * DM, F.lane); }
#undef IN
#undef SEAM
}

extern "C" void kernel_launch(void* const* d_in, const int* in_sizes, int n_in, void* d_out, int out_size, void* d_ws, size_t ws_size, hipStream_t stream) {
    static int grid = 0;
    if (grid == 0) {
        if (n_in != 24 || in_sizes[0] != MP * DM || (size_t)out_size != OUT_END || ws_size < WS_END) {
            fprintf(stderr, "kernel_launch: unexpected shapes: n_in %d in0 %d out %d (want %zu) ws %zu (want >= %zu)\n", n_in, n_in > 0 ? in_sizes[0] : -1, out_size, (size_t)OUT_END, ws_size, (size_t)WS_END); grid = -1; return; }
        int dev = 0, cus = 0, per_cu = 0;
        if (hipGetDevice(&dev) != hipSuccess || hipDeviceGetAttribute(&cus, hipDeviceAttributeMultiprocessorCount, dev) != hipSuccess) { fprintf(stderr, "kernel_launch: device query failed\n"); grid = -1; return; }
        if (hipFuncSetAttribute((const void*)mega_fwd, hipFuncAttributeMaxDynamicSharedMemorySize, LDS_BYTES) != hipSuccess) { fprintf(stderr, "kernel_launch: hipFuncSetAttribute failed\n"); grid = -1; return; }
        if (hipOccupancyMaxActiveBlocksPerMultiprocessor(&per_cu, (const void*)mega_fwd, NTHR, LDS_BYTES) != hipSuccess || per_cu < 1) { fprintf(stderr, "kernel_launch: occupancy query says %d blocks per CU\n", per_cu); }
        (void)hipGetLastError();
        grid = cus;
    }
    if (grid < 0) return;
    (void)hipMemsetAsync((char*)d_ws + WS_CTL, 0, CTL_ZERO_BYTES, stream);
    Args a{};
    for (int i = 0; i < 24; ++i) a.in[i] = (const float*)d_in[i];
    a.out = (float*)d_out; a.ws = (unsigned char*)d_ws;
#if MK_ONE_LAUNCH
    a.ph_lo = 0; a.ph_hi = NPH;
    hipLaunchKernelGGL(mega_fwd, dim3(grid), dim3(NTHR), LDS_BYTES, stream, a);
#else
    for (int p = 0; p < NPH; ++p) { a.ph_lo = p; a.ph_hi = p + 1; hipLaunchKernelGGL(mega_fwd, dim3(grid), dim3(NTHR), LDS_BYTES, stream, a); }
#endif
    const hipError_t le = hipPeekAtLastError();
    if (le != hipSuccess) fprintf(stderr, "kernel_launch: launch failed: %s\n", hipGetErrorName(le));
}
```

```cpp
#include <hip/hip_runtime.h>
#include <cstdio>
#include <cstdint>

#define GAS __attribute__((address_space(1)))
#define LAS __attribute__((address_space(3)))
typedef unsigned short bf16;
typedef unsigned v4u __attribute__((ext_vector_type(4)));
typedef unsigned v2u __attribute__((ext_vector_type(2)));
typedef float f32x2 __attribute__((ext_vector_type(2)));
typedef float f32x4 __attribute__((ext_vector_type(4)));
typedef float f32x16 __attribute__((ext_vector_type(16)));
typedef short bf16x8 __attribute__((ext_vector_type(8)));
typedef short s16x4 __attribute__((ext_vector_type(4)));
typedef __bf16 bf16x2_t __attribute__((ext_vector_type(2)));
typedef GAS unsigned gu32;
#define RLX_AGENT __ATOMIC_RELAXED, __HIP_MEMORY_SCOPE_AGENT
#define DI __device__ __forceinline__

DI unsigned pk2(float lo, float hi) { f32x2 v = {lo, hi}; bf16x2_t b = __builtin_convertvector(v, bf16x2_t); return __builtin_bit_cast(unsigned, b); }
DI float bflo(unsigned u) { return __uint_as_float(u << 16); }
DI float bfhi(unsigned u) { return __uint_as_float(u & 0xffff0000u); }
DI float wave_sum(float v) {
#pragma unroll
    for (int o = 1; o < 64; o <<= 1) v += __shfl_xor(v, o);
    return v;
}
DI int crow(int reg, int h) { return (reg & 3) + 8 * (reg >> 2) + 4 * h; }
#define MFMA32(a, b, c) __builtin_amdgcn_mfma_f32_32x32x16_bf16((a), (b), (c), 0, 0, 0)
DI s16x4 trr(const LAS unsigned char* p) { return __builtin_bit_cast(s16x4, __builtin_amdgcn_ds_read_tr16_b64_v4i16((LAS s16x4*)p)); }
DI bf16x8 cat8(s16x4 lo, s16x4 hi) { return __builtin_shufflevector(lo, hi, 0, 1, 2, 3, 4, 5, 6, 7); }
DI bf16x8 pack8(float a0, float a1, float a2, float a3, float a4, float a5, float a6, float a7) {
    v4u p; p.x = pk2(a0, a1); p.y = pk2(a2, a3); p.z = pk2(a4, a5); p.w = pk2(a6, a7); return __builtin_bit_cast(bf16x8, p);
}
DI float fexp2(float x) { return __builtin_amdgcn_exp2f(x); }
DI float fexp(float x) { return __builtin_amdgcn_exp2f(x * 1.4426950408889634f); }
DI float sigmoidf_(float x) { return 1.0f / (1.0f + fexp(-x)); }
DI float siluf_(float x) { return x * sigmoidf_(x); }
DI float softplusf_(float x) { return x > 20.f ? x : log1pf(__expf(x)); }

namespace pg8 {
#define PG8_LAS __attribute__((address_space(3)))
typedef unsigned short bf16_t;
typedef short bf16x8 __attribute__((ext_vector_type(8)));
typedef float f32x4 __attribute__((ext_vector_type(4)));
typedef unsigned u32x4 __attribute__((ext_vector_type(4)));
constexpr int BM = 256, BK = 64, HALF = 128, HTB = HALF * BK * 2  , STAGE_BYTES = 8 * HTB, NXCD = 8, WGM = 8;

__host__ __device__ __forceinline__ int lds_byte(int r, int c) { const int st = (r >> 4) * 2 + (c >> 5), rr = r & 15, cc = c & 31, ob = rr * 64 + cc * 2; return st * 1024 + (ob ^ (((ob >> 9) & 1) << 5)); }
__host__ __device__ __forceinline__ void stage_rc(int b, int& R, int& C) { const int st = b / 1024, sb = b % 1024, swz = sb ^ (((sb >> 9) & 1) << 5); R = (st >> 1) * 16 + swz / 64; C = (st & 1) * 32 + (swz % 64) / 2; }
__host__ __device__ __forceinline__ int perm32(int rho) { const int n = rho >> 4, i = rho & 15; return 8 * (i >> 2) + 4 * n + (i & 3); }

struct Unit { int pm, pn, k0, nt; };
struct Gemm { const bf16_t* A; const bf16_t* Bt; int M, N, K; };

struct StaticOrder {
    int nM, nN, nwg, G, c, ntf;
    __host__ __device__ void init(int M, int N, int G_, int c_, int K_) { nM = M / BM; nN = N / BM; nwg = nM * nN; G = G_; c = c_; ntf = K_ / BK; }
    __host__ __device__ bool next(int i, Unit& u) const {
        const long L = (long)i * G + c; if (L >= nwg) return false;
        int wgid = (int)L; { const int q = nwg / NXCD, r = nwg % NXCD, xcd = wgid % NXCD, off = wgid / NXCD; wgid = (xcd < r ? xcd * (q + 1) : r * (q + 1) + (xcd - r) * q) + off; }
        const int nig = WGM * nN, gid = wgid / nig, fm = gid * WGM, gsz = (nM - fm) < WGM ? (nM - fm) : WGM;
        u.pm = fm + ((wgid % nig) % gsz); u.pn = (wgid % nig) / gsz; u.k0 = 0; u.nt = ntf; return true;
    }
    __device__ __forceinline__ void a_ready(const Unit&) const {}
    __device__ __forceinline__ void done(const Unit&) const {}
};

template <class Epi, class Sched, bool ALIGN_EPI = false, bool SP2 = false>
__device__ __forceinline__ void gemm_phase(PG8_LAS unsigned char* lds, const Gemm g, const Sched& S, const Epi& E) {
    const int tid = threadIdx.x, wid = __builtin_amdgcn_readfirstlane(tid >> 6), lane = tid & 63, wr = wid >> 2, wc = wid & 3, fr = lane & 15, fq = lane >> 4;
    const int K = g.K;
    unsigned voffA[2], voffB[2];
#pragma unroll
    for (int i = 0; i < 2; ++i) { int R, C; stage_rc(tid * 16 + i * 8192, R, C); const int Rb = Epi::PERM ? ((R & ~31) + perm32(R & 31)) : R;
        voffA[i] = (unsigned)(R * K + C) * 2u; voffB[i] = (unsigned)(Rb * K + C) * 2u; }
    const size_t kstep = (size_t)(BK * 2);
    const size_t hstep = (size_t)HALF * K * 2;
    const size_t tstep = 2 * hstep;
    const unsigned ldsw = (unsigned)wid * 1024u;
    const int aoff = lds_byte(wr * 64 + fr, fq * 8), boff = lds_byte(wc * 32 + fr, fq * 8);
#define PG8_SA(b, h) (((b) * 2 + (h)) * HTB)
#define PG8_SB(b, h) ((4 + (b) * 2 + (h)) * HTB)
#define PG8_STAGE(bufoff, gbase, voff) do { _Pragma("unroll") for (int _i = 0; _i < 2; ++_i) \
        __builtin_amdgcn_global_load_lds((const unsigned*)((const char*)(gbase) + (voff)[_i]), (PG8_LAS unsigned*)(lds + (bufoff) + ldsw + _i * 8192), 16, 0, 0); } while (0)
#define PG8_LDA(dst, b, h) do { _Pragma("unroll") for (int m = 0; m < 4; ++m) _Pragma("unroll") for (int k = 0; k < 2; ++k) dst[m][k] = *(const PG8_LAS bf16x8*)(lds + PG8_SA(b, h) + aoff + m * 2048 + k * 1024); } while (0)
#define PG8_LDB(dst, b, h) do { _Pragma("unroll") for (int n = 0; n < 2; ++n) _Pragma("unroll") for (int k = 0; k < 2; ++k) dst[n][k] = *(const PG8_LAS bf16x8*)(lds + PG8_SB(b, h) + boff + n * 2048 + k * 1024); } while (0)
#define PG8_MMA(ai, bj, At, Bt) do { __builtin_amdgcn_s_setprio(1); _Pragma("unroll") for (int m = 0; m < 4; ++m) _Pragma("unroll") for (int n = 0; n < 2; ++n) _Pragma("unroll") for (int k = 0; k < 2; ++k) \
        acc[ai][bj][m][n] = __builtin_amdgcn_mfma_f32_16x16x32_bf16(Bt[n][k], At[m][k], acc[ai][bj][m][n], 0, 0, 0); __builtin_amdgcn_s_setprio(0); } while (0)
#define PG8_WAIT_V(n) asm volatile("s_waitcnt vmcnt(" #n ")" ::: "memory")
#define PG8_WAIT_L(n) asm volatile("s_waitcnt lgkmcnt(" #n ")" ::: "memory")
#define PG8_BAR __builtin_amdgcn_s_barrier()
#define PG8_SCHED __builtin_amdgcn_sched_barrier(0)
    Unit cur, nxt; int ui = 0;
    if (!S.next(0, cur)) return;
    f32x4 acc[2][2][4][2];
#pragma unroll
    for (int a = 0; a < 2; ++a)
#pragma unroll
        for (int b = 0; b < 2; ++b)
#pragma unroll
            for (int m = 0; m < 4; ++m)
#pragma unroll
                for (int n = 0; n < 2; ++n) acc[a][b][m][n] = (f32x4){0.f, 0.f, 0.f, 0.f};
    bf16x8 At[4][2], B0[2][2], B1[2][2];
    const char* cA = (const char*)g.A + (size_t)cur.pm * tstep + (size_t)cur.k0 * 2; const char* cB = (const char*)g.Bt + (size_t)cur.pn * tstep + (size_t)cur.k0 * 2;
    S.a_ready(cur);
    if constexpr (SP2) {
        PG8_STAGE(PG8_SB(0, 0), cB, voffB); PG8_STAGE(PG8_SB(0, 1), cB + hstep, voffB); PG8_STAGE(PG8_SA(0, 0), cA, voffA); PG8_STAGE(PG8_SA(0, 1), cA + hstep, voffA);
        if (wr == 1) PG8_BAR;
        PG8_WAIT_V(2); PG8_BAR;
        PG8_STAGE(PG8_SB(1, 0), cB + kstep, voffB); PG8_STAGE(PG8_SA(1, 0), cA + kstep, voffA); PG8_STAGE(PG8_SB(1, 1), cB + hstep + kstep, voffB);
        PG8_WAIT_V(6); PG8_BAR;
    } else {
        PG8_STAGE(PG8_SB(0, 0), cB, voffB); PG8_STAGE(PG8_SA(0, 0), cA, voffA); PG8_STAGE(PG8_SB(0, 1), cB + hstep, voffB); PG8_STAGE(PG8_SA(0, 1), cA + hstep, voffA);
        if (wr == 1) PG8_BAR;
        PG8_WAIT_V(4); PG8_BAR;
        PG8_STAGE(PG8_SB(1, 0), cB + kstep, voffB); PG8_STAGE(PG8_SA(1, 0), cA + kstep, voffA); PG8_STAGE(PG8_SB(1, 1), cB + hstep + kstep, voffB);
        PG8_WAIT_V(6); PG8_BAR;
    }
    for (;;) {
        const bool has_next = S.next(ui + 1, nxt);
        const char* nA = has_next ? (const char*)g.A + (size_t)nxt.pm * tstep + (size_t)nxt.k0 * 2 : cA; const char* nB = has_next ? (const char*)g.Bt + (size_t)nxt.pn * tstep + (size_t)nxt.k0 * 2 : cB;
        const int nt = cur.nt;
        for (int t = 0; t < nt; t += 2) {
            const bool last = (t == nt - 2);
            const char* a1 = cA + (size_t)(t + 1) * kstep;
            const char* a2 = last ? nA : cA + (size_t)(t + 2) * kstep; const char* b2 = last ? nB : cB + (size_t)(t + 2) * kstep;
            const char* a3 = a2 + kstep; const char* b3 = b2 + kstep;
            if (last && has_next) S.a_ready(nxt);
            if constexpr (SP2) {
            PG8_LDB(B0, 0, 0); PG8_LDB(B1, 0, 1); PG8_SCHED; PG8_LDA(At, 0, 0); PG8_STAGE(PG8_SA(1, 1), a1 + hstep, voffA);
            PG8_WAIT_V(8); PG8_WAIT_L(0); PG8_BAR; PG8_MMA(0, 0, At, B0); PG8_MMA(0, 1, At, B1); PG8_BAR; PG8_SCHED;
            PG8_LDA(At, 0, 1); PG8_STAGE(PG8_SB(0, 0), b2, voffB); PG8_STAGE(PG8_SB(0, 1), b2 + hstep, voffB); PG8_STAGE(PG8_SA(0, 0), a2, voffA);
            PG8_WAIT_V(8); PG8_WAIT_L(0); PG8_BAR; PG8_MMA(1, 0, At, B0); PG8_MMA(1, 1, At, B1); PG8_BAR; PG8_SCHED;
            PG8_LDB(B0, 1, 0); PG8_LDB(B1, 1, 1); PG8_SCHED; PG8_LDA(At, 1, 0); PG8_STAGE(PG8_SA(0, 1), a2 + hstep, voffA);
            PG8_WAIT_V(8); PG8_WAIT_L(0); PG8_BAR; PG8_MMA(0, 0, At, B0); PG8_MMA(0, 1, At, B1); PG8_BAR; PG8_SCHED;
            PG8_LDA(At, 1, 1); PG8_STAGE(PG8_SB(1, 0), b3, voffB); PG8_STAGE(PG8_SB(1, 1), b3 + hstep, voffB); PG8_STAGE(PG8_SA(1, 0), a3, voffA);
            PG8_WAIT_V(8); PG8_WAIT_L(0); PG8_BAR; PG8_MMA(1, 0, At, B0); PG8_MMA(1, 1, At, B1); PG8_BAR; PG8_SCHED;
            } else {
            PG8_LDB(B0, 0, 0); PG8_SCHED; PG8_LDA(At, 0, 0); PG8_STAGE(PG8_SA(1, 1), a1 + hstep, voffA);
            PG8_WAIT_L(8); PG8_BAR; PG8_WAIT_L(0); PG8_MMA(0, 0, At, B0); PG8_BAR; PG8_SCHED;
            PG8_LDB(B1, 0, 1); PG8_STAGE(PG8_SB(0, 0), b2, voffB);
            PG8_BAR; PG8_WAIT_L(0); PG8_MMA(0, 1, At, B1); PG8_BAR;
            PG8_LDA(At, 0, 1); PG8_STAGE(PG8_SA(0, 0), a2, voffA);
            PG8_BAR; PG8_WAIT_L(0); PG8_MMA(1, 0, At, B0); PG8_BAR; PG8_SCHED;
            PG8_STAGE(PG8_SB(0, 1), b2 + hstep, voffB);
            PG8_WAIT_V(6); PG8_BAR; PG8_MMA(1, 1, At, B1); PG8_BAR;
            PG8_LDB(B0, 1, 0); PG8_SCHED; PG8_LDA(At, 1, 0); PG8_STAGE(PG8_SA(0, 1), a2 + hstep, voffA);
            PG8_WAIT_L(8); PG8_BAR; PG8_WAIT_L(0); PG8_MMA(0, 0, At, B0); PG8_BAR; PG8_SCHED;
            PG8_LDB(B1, 1, 1); PG8_STAGE(PG8_SB(1, 0), b3, voffB);
            PG8_BAR; PG8_WAIT_L(0); PG8_MMA(0, 1, At, B1); PG8_BAR;
            PG8_LDA(At, 1, 1); PG8_STAGE(PG8_SA(1, 0), a3, voffA);
            PG8_BAR; PG8_WAIT_L(0); PG8_MMA(1, 0, At, B0); PG8_BAR; PG8_SCHED;
            PG8_STAGE(PG8_SB(1, 1), b3 + hstep, voffB);
            PG8_WAIT_V(6); PG8_BAR; PG8_MMA(1, 1, At, B1); PG8_BAR;
            }
        }
        if constexpr (ALIGN_EPI) { if (wr == 0) PG8_BAR; }
        if constexpr (!Epi::AFTER_DRAIN) { E(acc, cur, wr, wc, fr, fq); S.done(cur); }
        if (!has_next) break;
#pragma unroll
        for (int a = 0; a < 2; ++a)
#pragma unroll
            for (int b = 0; b < 2; ++b)
#pragma unroll
                for (int m = 0; m < 4; ++m)
#pragma unroll
                    for (int n = 0; n < 2; ++n) acc[a][b][m][n] = (f32x4){0.f, 0.f, 0.f, 0.f};
        cur = nxt; cA = nA; cB = nB; ++ui;
        if constexpr (ALIGN_EPI) { if (wr == 1) PG8_BAR; }
    }
    PG8_WAIT_V(0);
    if constexpr (!ALIGN_EPI) { if (wr == 0) PG8_BAR; }
    PG8_BAR;
    if constexpr (Epi::AFTER_DRAIN) { E.fused(acc, cur, wr, wc, fr, fq, lds, wid, lane); S.done(cur); }
#undef PG8_SA
#undef PG8_SB
#undef PG8_STAGE
#undef PG8_LDA
#undef PG8_LDB
#undef PG8_MMA
#undef PG8_WAIT_V
#undef PG8_WAIT_L
#undef PG8_BAR
#undef PG8_SCHED
}
}

constexpr int NWAVES = 8, NTHR = 512;
constexpr int DM = 2048, MP = 8192, MS = 512, MROWS = MP + MS;
constexpr int N1 = 8448, N5 = 7168, FF = 8192, KMIX = 4096;
constexpr int C_Z = 0, C_XBC = 2048, C_Q = 5120, C_K = 7168, C_V = 7680, C_DT = 8192;
constexpr int O_Q = 0, O_K = 6144, O_V = 6656;
constexpr int CONVD = 3072;
constexpr float EPS = 1e-5f;
constexpr int NPH = 18;
#ifndef MK_ONE_LAUNCH
#define MK_ONE_LAUNCH 1
#endif

constexpr size_t OUT_YP = 0, OUT_YS = OUT_YP + (size_t)MP * DM, OUT_PCONV = OUT_YS + (size_t)MS * DM, OUT_PSSM = OUT_PCONV + 3 * CONVD,
    OUT_PSWAK = OUT_PSSM + 32 * 64 * 128, OUT_PSWAV = OUT_PSWAK + 128 * 512, OUT_PDILK = OUT_PSWAV + 128 * 512, OUT_PDILV = OUT_PDILK + 2048 * 512,
    OUT_SCONV = OUT_PDILV + 2048 * 512, OUT_SSSM = OUT_SCONV + 128 * 3 * CONVD, OUT_SSWAK = OUT_SSSM + (size_t)128 * 32 * 64 * 128,
    OUT_SSWAV = OUT_SSWAK + 512 * 512, OUT_SDILK = OUT_SSWAV + 512 * 512, OUT_SDILV = OUT_SDILK + 512 * 512, OUT_END = OUT_SDILV + 512 * 512;

constexpr size_t MiB = 1u << 20;
constexpr size_t WS_CTL = 0, CTL_ZERO_BYTES = 1 * MiB;
constexpr size_t WS_ROPE = 1 * MiB, WS_DT = 2 * MiB, WS_CD = 4 * MiB, WS_LSE = 5 * MiB;
constexpr size_t WS_W1T = 16 * MiB, WS_W2T = 50 * MiB, WS_WM1T = 66 * MiB, WS_WM2T = 130 * MiB, WS_W5T = 194 * MiB, WS_W6T = 222 * MiB;
constexpr size_t WS_XN = 230 * MiB, WS_P1 = 264 * MiB, WS_XC = 405 * MiB, WS_ST = 453 * MiB, WS_HIN = 517 * MiB, WS_MIX = 549 * MiB, WS_H = 617 * MiB;
constexpr size_t WS_U = 685 * MiB, WS_P5 = 821 * MiB, WS_O3 = 940 * MiB, WS_MRG = 1042 * MiB, WS_PART = 1076 * MiB, WS_END = 1140 * MiB;
static_assert(WS_W1T + (size_t)N1 * DM * 2 <= WS_W2T && WS_P1 + (size_t)MROWS * N1 * 2 <= WS_XC && WS_U + (size_t)MROWS * FF * 2 <= WS_P5 && WS_P5 + (size_t)MROWS * N5 * 2 <= WS_O3 && WS_O3 + (size_t)3 * MROWS * DM * 2 <= WS_MRG, "ws map");
constexpr int CW_TMO = 0, CW_BAR = 4096;

constexpr int LDS_BYTES = 163840 - 1024;
constexpr int MISC_OFF = LDS_BYTES - 256;

#define XB_TMO      128
#define XB_XCNT(j)  (256  + 64 * (j))
#define XB_XSUB(j)  (1280 + 64 * (j))
#define XB_XGEN(j)  (2304 + 64 * (j))
#define XB_TOP      3328
#define XB_TOPGEN   3392
#define XCD_BAR_WORDS 3456
#define XB_SPIN_CAP (1u << 18)

__device__ __forceinline__ unsigned xb_ld(unsigned* p)              { return __hip_atomic_load(p, __ATOMIC_RELAXED, __HIP_MEMORY_SCOPE_AGENT); }
__device__ __forceinline__ unsigned xb_add(unsigned* p, unsigned v) { return __hip_atomic_fetch_add(p, v, __ATOMIC_RELAXED, __HIP_MEMORY_SCOPE_AGENT); }
__device__ __forceinline__ unsigned xb_xcc_id() { return (unsigned)__builtin_amdgcn_s_getreg((3 << 11) | 20) & 0xFu; }
#define XB_SPIN(cond, bar) do { unsigned _sp = 0; while (cond) { __builtin_amdgcn_s_sleep(1); \
    if ((++_sp & 255u) == 0u) { if (xb_ld(&(bar)[XB_TMO])) break; if (_sp > XB_SPIN_CAP) { atomicAdd(&(bar)[XB_TMO], 1u); break; } } } } while (0)

struct XcdBarrier {
    unsigned* bar; unsigned x;
    volatile LAS unsigned* st;
};

__device__ __forceinline__ XcdBarrier xcd_barrier_post(unsigned* bar, volatile LAS unsigned* st) {
    XcdBarrier b; b.bar = bar; b.x = xb_xcc_id(); b.st = st;
    if (threadIdx.x == 0) (void)xb_add(&bar[XB_XCNT(b.x)], 1u);
    return b;
}
__device__ __forceinline__ void xcd_barrier_complete(unsigned* bar, unsigned x, unsigned& nloc, unsigned& nx) {
    const unsigned G = gridDim.x * gridDim.y * gridDim.z;
    unsigned sum, cnt, mine, sp = 0u;
    for (;;) {
        sum = 0u; cnt = 0u; mine = 0u;
#pragma unroll
        for (unsigned j = 0; j < 16; ++j) { const unsigned c = xb_ld(&bar[XB_XCNT(j)]); sum += c; cnt += (c > 0u) ? 1u : 0u; mine = (j == x) ? c : mine; }
        if (sum == G) break;
        __builtin_amdgcn_s_sleep(1);
        if ((++sp & 255u) == 0u) { if (xb_ld(&bar[XB_TMO])) break; if (sp > XB_SPIN_CAP) { atomicAdd(&bar[XB_TMO], 1u); break; } }
    }
    nloc = mine > 0u ? mine : 1u; nx = cnt > 0u ? cnt : 1u;
}

__device__ __forceinline__ void xcd_barrier(const XcdBarrier& b) {
    asm volatile("s_waitcnt vmcnt(0)" ::: "memory");
    __syncthreads();
    if (threadIdx.x == 0) {
        unsigned* bar = b.bar;
        __builtin_amdgcn_s_waitcnt(0);
        unsigned nloc = b.st[0], nx = b.st[1];
        if (nloc == 0u) { xcd_barrier_complete(bar, b.x, nloc, nx); b.st[0] = nloc; b.st[1] = nx; }
        const unsigned old = xb_add(&bar[XB_XSUB(b.x)], 1u);
        const unsigned gen = old / nloc;
        if (old + 1u == (gen + 1u) * nloc) {
            __builtin_amdgcn_fence(__ATOMIC_RELEASE, "agent");
            asm volatile("s_waitcnt vmcnt(0)" ::: "memory");
            const unsigned og = xb_add(&bar[XB_TOP], 1u);
            const unsigned tg = og / nx;
            if (og + 1u == (tg + 1u) * nx) xb_add(&bar[XB_TOPGEN], 1u);
            else XB_SPIN(xb_ld(&bar[XB_TOPGEN]) == tg, bar);
            __builtin_amdgcn_fence(__ATOMIC_ACQUIRE, "agent");
            xb_add(&bar[XB_XGEN(b.x)], 1u);
            asm volatile("s_waitcnt vmcnt(0)" ::: "memory");
        } else {
            XB_SPIN(xb_ld(&bar[XB_XGEN(b.x)]) == gen, bar);
            __builtin_amdgcn_fence(__ATOMIC_ACQUIRE, "agent");
            asm volatile("s_waitcnt vmcnt(0)" ::: "memory");
        }
    }
    __syncthreads();
}

namespace pg8 {
DI void st_bf16x8(bf16* p, f32x4 v0, f32x4 v1) { v4u w; w.x = pk2(v0[0], v0[1]); w.y = pk2(v0[2], v0[3]); w.z = pk2(v1[0], v1[1]); w.w = pk2(v1[2], v1[3]); *(v4u*)p = w; }
DI void st_f32x8(float* p, f32x4 v0, f32x4 v1) { *(f32x4*)p = v0; *(f32x4*)(p + 4) = v1; }
DI int row_pos(int r) { return r < MP ? r : MP + (r & 3); }
DI void rope8(f32x4& v0, f32x4& v1, const float* rope, int pos, int fq) {
    f32x4 o0, o1;
#pragma unroll
    for (int e = 0; e < 4; ++e) { o0[e] = __shfl_xor(v0[e], 16); o1[e] = __shfl_xor(v1[e], 16); }
    if (fq < 2) {
        const f32x4 c0 = *(const f32x4*)(rope + pos * 16), c1 = *(const f32x4*)(rope + pos * 16 + 4), s0 = *(const f32x4*)(rope + pos * 16 + 8), s1 = *(const f32x4*)(rope + pos * 16 + 12);
        const float sg = fq == 0 ? -1.f : 1.f;
        v0 = v0 * c0 + (o0 * s0) * sg; v1 = v1 * c1 + (o1 * s1) * sg;
    }
}
struct EpiProj1 {
    static constexpr bool PERM = true, AFTER_DRAIN = false;
    bf16* P1; float* DT; const float* rope; float* out;
    DI void operator()(const f32x4 (&acc)[2][2][4][2], const Unit& u, int wr, int wc, int fr, int fq) const {
        const int pn = u.pn, row0 = u.pm * BM + wr * 64 + fr;
        if (pn == 32) {
            if (wc == 0) {
#pragma unroll
                for (int ai = 0; ai < 2; ++ai)
#pragma unroll
                    for (int m = 0; m < 4; ++m) { const int r = row0 + ai * HALF + m * 16; st_f32x8(DT + (size_t)r * 32 + 8 * fq, acc[ai][0][m][0], acc[ai][0][m][1]); }
            }
            return;
        }
        const bool dorope = (pn >= 20 && pn < 30) && ((wc & 1) == 0);
#pragma unroll
        for (int ai = 0; ai < 2; ++ai)
#pragma unroll
            for (int m = 0; m < 4; ++m) {
                const int r = row0 + ai * HALF + m * 16, pos = row_pos(r);
#pragma unroll
                for (int bj = 0; bj < 2; ++bj) {
                    const int cb = pn * BM + bj * HALF + wc * 32 + 8 * fq;
                    f32x4 v0 = acc[ai][bj][m][0], v1 = acc[ai][bj][m][1];
                    if (dorope) rope8(v0, v1, rope, pos, fq);
                    st_bf16x8(P1 + (size_t)r * N1 + cb, v0, v1);
                    if (u.pm >= 31) {
                        if (pn >= 8 && pn < 20) {
                            const int c = cb - C_XBC;
                            if (r >= MP - 3 && r < MP) st_f32x8(out + OUT_PCONV + (size_t)(r - (MP - 3)) * CONVD + c, v0, v1);
                            if (r >= MP) { const int t = (r - MP) & 3, b = (r - MP) >> 2; if (t >= 1) st_f32x8(out + OUT_SCONV + ((size_t)b * 3 + (t - 1)) * CONVD + c, v0, v1); }
                        } else if (pn >= 28 && pn < 30) {
                            const int c = cb - C_K;
                            if (r >= MP - 128 && r < MP) st_f32x8(out + OUT_PSWAK + (size_t)(r - (MP - 128)) * 512 + c, v0, v1);
                            if (r >= MP) st_f32x8(out + OUT_SSWAK + (size_t)(r - MP) * 512 + c, v0, v1);
                        } else if (pn >= 30) {
                            const int c = cb - C_V;
                            if (r >= MP - 128 && r < MP) st_f32x8(out + OUT_PSWAV + (size_t)(r - (MP - 128)) * 512 + c, v0, v1);
                            if (r >= MP) st_f32x8(out + OUT_SSWAV + (size_t)(r - MP) * 512 + c, v0, v1);
                        }
                    }
                }
            }
    }
};
struct EpiProj5 {
    static constexpr bool PERM = true, AFTER_DRAIN = false;
    bf16* P5; const float* rope; float* out;
    DI void operator()(const f32x4 (&acc)[2][2][4][2], const Unit& u, int wr, int wc, int fr, int fq) const {
        const int pn = u.pn, row0 = u.pm * BM + wr * 64 + fr;
        const bool dorope = (pn < 26) && ((wc & 1) == 0);
#pragma unroll
        for (int ai = 0; ai < 2; ++ai)
#pragma unroll
            for (int m = 0; m < 4; ++m) {
                const int r = row0 + ai * HALF + m * 16, pos = row_pos(r);
#pragma unroll
                for (int bj = 0; bj < 2; ++bj) {
                    const int cb = pn * BM + bj * HALF + wc * 32 + 8 * fq;
                    f32x4 v0 = acc[ai][bj][m][0], v1 = acc[ai][bj][m][1];
                    if (dorope) rope8(v0, v1, rope, pos, fq);
                    st_bf16x8(P5 + (size_t)r * N5 + cb, v0, v1);
                    if (u.pm >= 24 && pn >= 24) {
                        const bool isk = pn < 26; const int c = cb - (isk ? O_K : O_V);
                        if (r >= MP - 2048 && r < MP) st_f32x8(out + (isk ? OUT_PDILK : OUT_PDILV) + (size_t)(r - (MP - 2048)) * 512 + c, v0, v1);
                        if (r >= MP) st_f32x8(out + (isk ? OUT_SDILK : OUT_SDILV) + (size_t)(r - MP) * 512 + c, v0, v1);
                    }
                }
            }
    }
};
struct SplitOrder {
    StaticOrder P; int K;
    DI void init(int G_, int c_, int K_) { P.init(MP, DM, G_, c_, K_); K = K_; }
    DI bool next(int i, Unit& u) const {
        const int L = i * P.G + P.c; if (L >= 512) return false;
        if (L < 256) { const int q = L / P.G; StaticOrder T = P; T.c = L - q * P.G; return T.next(q, u); }
        const int s = L - 256, unit = s >> 4, sl = s & 15; u.pm = 32 + (unit >> 3); u.pn = unit & 7; u.k0 = sl * (K / 16); u.nt = K / 16 / BK; return true;
    }
    DI void a_ready(const Unit&) const {}
    DI void done(const Unit&) const {}
};
struct EpiRes {
    static constexpr bool PERM = true, AFTER_DRAIN = false;
    const float* resP; float* H; float* PART;
    DI void operator()(const f32x4 (&acc)[2][2][4][2], const Unit& u, int wr, int wc, int fr, int fq) const {
        const int row0 = u.pm * BM + wr * 64 + fr;
        if (u.pm >= 32) {
            float* pb = PART + (size_t)(u.k0 / (u.nt * BK)) * MS * DM;
#pragma unroll
            for (int ai = 0; ai < 2; ++ai)
#pragma unroll
                for (int m = 0; m < 4; ++m) {
                    const int r = row0 + ai * HALF + m * 16 - MP;
#pragma unroll
                    for (int bj = 0; bj < 2; ++bj) st_f32x8(pb + (size_t)r * DM + u.pn * BM + bj * HALF + wc * 32 + 8 * fq, acc[ai][bj][m][0], acc[ai][bj][m][1]);
                }
            return;
        }
#pragma unroll
        for (int ai = 0; ai < 2; ++ai)
#pragma unroll
            for (int m = 0; m < 4; ++m) {
                const int r = row0 + ai * HALF + m * 16;
                const float* rp = resP + (size_t)r * DM;
#pragma unroll
                for (int bj = 0; bj < 2; ++bj) {
                    const int cb = u.pn * BM + bj * HALF + wc * 32 + 8 * fq;
                    const f32x4 a0 = *(const f32x4*)(rp + cb), a1 = *(const f32x4*)(rp + cb + 4);
                    st_f32x8(H + (size_t)r * DM + cb, acc[ai][bj][m][0] + a0, acc[ai][bj][m][1] + a1);
                }
            }
    }
};
struct EpiSq {
    static constexpr bool PERM = true, AFTER_DRAIN = false;
    bf16* U;
    DI void operator()(const f32x4 (&acc)[2][2][4][2], const Unit& u, int wr, int wc, int fr, int fq) const {
        const int row0 = u.pm * BM + wr * 64 + fr;
#pragma unroll
        for (int ai = 0; ai < 2; ++ai)
#pragma unroll
            for (int m = 0; m < 4; ++m) {
                const int r = row0 + ai * HALF + m * 16;
#pragma unroll
                for (int bj = 0; bj < 2; ++bj) {
                    const int cb = u.pn * BM + bj * HALF + wc * 32 + 8 * fq;
                    f32x4 v0 = acc[ai][bj][m][0], v1 = acc[ai][bj][m][1];
#pragma unroll
                    for (int e = 0; e < 4; ++e) { const float a = fmaxf(v0[e], 0.f), b = fmaxf(v1[e], 0.f); v0[e] = a * a; v1[e] = b * b; }
                    st_bf16x8(U + (size_t)r * FF + cb, v0, v1);
                }
            }
    }
};
}

struct Frame {
    LAS unsigned char* lds;
    int tid, lane, wave, G, bid;
    const float* const* in; float* out; unsigned char* ws;
};
#define LDS_WAIT() asm volatile("s_waitcnt lgkmcnt(0)" ::: "memory")

DI void transpose_item(const float* W, int N, bf16* WT, int K, int k0, int n0, int drow0, LAS float* scr, int lane) {
#pragma unroll 8
    for (int i = 0; i < 32; ++i) { const int kk = 2 * i + (lane >> 5); scr[kk * 33 + (lane & 31)] = W[(size_t)(k0 + kk) * N + n0 + (lane & 31)]; }
    LDS_WAIT(); asm volatile("" ::: "memory");
    const int c = lane & 7;
#pragma unroll
    for (int j = 0; j < 4; ++j) { const int n = (lane >> 3) + 8 * j; const LAS float* s = scr + (8 * c) * 33 + n;
        v4u o; o.x = pk2(s[0 * 33], s[1 * 33]); o.y = pk2(s[2 * 33], s[3 * 33]); o.z = pk2(s[4 * 33], s[5 * 33]); o.w = pk2(s[6 * 33], s[7 * 33]);
        *(GAS v4u*)(WT + (size_t)(drow0 + n) * K + k0 + 8 * c) = o; }
    LDS_WAIT(); asm volatile("" ::: "memory");
}
DI int remap_w1(int n) { return n < 5120 ? n : (n < 5152 ? n - 5120 + C_DT : n - 32); }
DI void rms_row_bf16(const float* xrow, const float* g, bf16* orow, int lane) {
    const GAS f32x4* xr = (const GAS f32x4*)xrow + lane;
    f32x4 v[8]; float s = 0.f;
#pragma unroll
    for (int j = 0; j < 8; ++j) { v[j] = xr[64 * j]; s += (v[j].x * v[j].x + v[j].y * v[j].y) + (v[j].z * v[j].z + v[j].w * v[j].w); }
    const float rs = 1.0f / sqrtf(wave_sum(s) * (1.f / DM) + EPS);
    const GAS f32x4* gr = (const GAS f32x4*)g + lane;
    GAS v2u* o8 = (GAS v2u*)orow + lane;
#pragma unroll
    for (int j = 0; j < 8; ++j) { const f32x4 gg = gr[64 * j]; v2u o; o.x = pk2(v[j].x * rs * gg.x, v[j].y * rs * gg.y); o.y = pk2(v[j].z * rs * gg.z, v[j].w * rs * gg.w); o8[64 * j] = o; }
}
DI void rms_row_f32(const float* xrow, const float* g, float* orow, int lane) {
    const GAS f32x4* xr = (const GAS f32x4*)xrow + lane;
    f32x4 v[8]; float s = 0.f;
#pragma unroll
    for (int j = 0; j < 8; ++j) { v[j] = xr[64 * j]; s += (v[j].x * v[j].x + v[j].y * v[j].y) + (v[j].z * v[j].z + v[j].w * v[j].w); }
    const float rs = 1.0f / sqrtf(wave_sum(s) * (1.f / DM) + EPS);
    const GAS f32x4* gr = (const GAS f32x4*)g + lane;
    GAS f32x4* o = (GAS f32x4*)orow + lane;
#pragma unroll
    for (int j = 0; j < 8; ++j) { const f32x4 gg = gr[64 * j]; o[64 * j] = v[j] * rs * gg; }
}
template <bool F32OUT>
DI void norm_sample_rows(Frame& F, float* HS, const float* g, bf16* XNS, float* OUTS) {
    LAS float* red = (LAS float*)F.lds;
    const float* PART = (const float*)(F.ws + WS_PART);
    for (int rp = F.bid; rp < MS / 2; rp += F.G) {
        const int row = 2 * rp + (F.wave >> 2), col = (F.wave & 3) * 512 + 4 * F.lane;
        float* hrow = HS + (size_t)row * DM; const float* prow = PART + (size_t)row * DM;
        f32x4 v0 = *(const GAS f32x4*)(hrow + col), v1 = *(const GAS f32x4*)(hrow + col + 256);
#pragma unroll
        for (int s = 0; s < 16; ++s) { v0 += *(const GAS f32x4*)(prow + (size_t)s * MS * DM + col); v1 += *(const GAS f32x4*)(prow + (size_t)s * MS * DM + col + 256); }
        *(GAS f32x4*)(hrow + col) = v0; *(GAS f32x4*)(hrow + col + 256) = v1;
        float ss = (v0.x * v0.x + v0.y * v0.y) + (v0.z * v0.z + v0.w * v0.w) + (v1.x * v1.x + v1.y * v1.y) + (v1.z * v1.z + v1.w * v1.w);
        ss = wave_sum(ss);
        __syncthreads();
        if (F.lane == 0) red[F.wave] = ss;
        __syncthreads();
        const int w0 = F.wave & 4; const float tot = (red[w0] + red[w0 + 1]) + (red[w0 + 2] + red[w0 + 3]);
        const float rs = 1.0f / sqrtf(tot * (1.f / DM) + EPS);
        const f32x4 g0 = *(const f32x4*)(g + col), g1 = *(const f32x4*)(g + col + 256);
        if (F32OUT) { *(GAS f32x4*)(OUTS + (size_t)row * DM + col) = v0 * rs * g0; *(GAS f32x4*)(OUTS + (size_t)row * DM + col + 256) = v1 * rs * g1; }
        else { v2u a, b; a.x = pk2(v0.x * rs * g0.x, v0.y * rs * g0.y); a.y = pk2(v0.z * rs * g0.z, v0.w * rs * g0.w); b.x = pk2(v1.x * rs * g1.x, v1.y * rs * g1.y); b.y = pk2(v1.z * rs * g1.z, v1.w * rs * g1.w);
            *(GAS v2u*)(XNS + (size_t)row * DM + col) = a; *(GAS v2u*)(XNS + (size_t)row * DM + col + 256) = b; }
    }
}
DI void norm_phase(Frame& F, const float* HP, float* HS, const float* g, bf16* XN, bool partials) {
    const int gw = F.bid * NWAVES + F.wave, NGW = F.G * NWAVES;
    if (partials) norm_sample_rows<false>(F, HS, g, XN + (size_t)MP * DM, nullptr);
    const int mend = partials ? MP : MROWS;
    for (int m = gw; m < mend; m += NGW) rms_row_bf16(m < MP ? HP + (size_t)m * DM : HS + (size_t)(m - MP) * DM, g, XN + (size_t)m * DM, F.lane);
}

DI void p0_prologue(Frame& F) {
    LAS float* scr = (LAS float*)(F.lds + F.wave * 16384);
    const int gw = F.bid * NWAVES + F.wave, NGW = F.G * NWAVES, lane = F.lane;
    unsigned char* ws = F.ws;
    constexpr int I0 = 32 * 257, I1 = 64 * 64, I2 = 32 * 256, I4 = 128 * 64, I6 = 32 * 224, I7 = 32 * 64;
    constexpr int NITEMS = I0 + I1 + 2 * I2 + 2 * I4 + I6 + I7;
    for (int it = gw; it < NITEMS; it += NGW) {
        int r = it;
        if (r < I0) { const int kb = r / 257, nb = r % 257; transpose_item(F.in[10], 8224, (bf16*)(ws + WS_W1T), 2048, 64 * kb, 32 * nb, remap_w1(32 * nb), scr, lane); continue; } r -= I0;
        if (r < I1) { const int kb = r / 64, nb = r % 64; transpose_item(F.in[18], 2048, (bf16*)(ws + WS_W2T), 4096, 64 * kb, 32 * nb, 32 * nb, scr, lane); continue; } r -= I1;
        if (r < 2 * I2) { const int l = r / I2, q = r % I2, kb = q / 256, nb = q % 256; transpose_item(F.in[21] + (size_t)l * 2048 * 8192, 8192, (bf16*)(ws + WS_WM1T) + (size_t)l * 8192 * 2048, 2048, 64 * kb, 32 * nb, 32 * nb, scr, lane); continue; } r -= 2 * I2;
        if (r < 2 * I4) { const int l = r / I4, q = r % I4, kb = q / 64, nb = q % 64; transpose_item(F.in[22] + (size_t)l * 8192 * 2048, 2048, (bf16*)(ws + WS_WM2T) + (size_t)l * 2048 * 8192, 8192, 64 * kb, 32 * nb, 32 * nb, scr, lane); continue; } r -= 2 * I4;
        if (r < I6) { const int kb = r / 224, nb = r % 224; transpose_item(F.in[19], 7168, (bf16*)(ws + WS_W5T), 2048, 64 * kb, 32 * nb, 32 * nb, scr, lane); continue; } r -= I6;
        { const int kb = r / 64, nb = r % 64; transpose_item(F.in[20], 2048, (bf16*)(ws + WS_W6T), 2048, 64 * kb, 32 * nb, 32 * nb, scr, lane); }
    }
    { GAS v4u* z = (GAS v4u*)((bf16*)(ws + WS_W1T) + (size_t)8224 * 2048); const int n16 = 224 * 2048 * 2 / 16;
      for (int i = F.bid * NTHR + F.tid; i < n16; i += F.G * NTHR) z[i] = (v4u){0u, 0u, 0u, 0u}; }
    { float* rope = (float*)(ws + WS_ROPE);
      for (int i = F.bid * NTHR + F.tid; i < 8196 * 8; i += F.G * NTHR) {
          const int pos = i >> 3, k = i & 7;
          const double invf = k == 0 ? 1.0 : k == 1 ? 0.193922758102417 : k == 2 ? 0.03760603442788124 : k == 3 ? 0.007292666472494602 : k == 4 ? 0.0014142136787995696 : k == 5 ? 0.00027424818836152554 : k == 6 ? 5.318298644851893e-05 : 1.031338433676865e-05;
          const float angf = (float)pos * (float)invf;
          const double rev = (double)angf * 0.15915494309189535;
          const float fr = (float)(rev - __builtin_rint(rev));
          rope[pos * 16 + k] = __builtin_amdgcn_cosf(fr); rope[pos * 16 + 8 + k] = __builtin_amdgcn_sinf(fr);
      } }
    { const GAS f32x4* src = (const GAS f32x4*)F.in[1]; GAS f32x4* dst = (GAS f32x4*)((float*)(ws + WS_H) + (size_t)MP * DM);
      for (int i = F.bid * NTHR + F.tid; i < MS * DM / 4; i += F.G * NTHR) dst[i] = src[i]; }
    norm_phase(F, F.in[0], (float*)F.in[1], F.in[8], (bf16*)(ws + WS_XN), false);
}

constexpr int AT_KSTR = 144;
constexpr int AT_K = 0, AT_V = 256 * AT_KSTR;
template <bool SINK>
DI void attn_prompt_unit(Frame& F, const bf16* QKV, int ld, int qcol0, int kcol, int vcol, int dil, int rho, int cb, int maxd,
                         const float* sink4, bf16* O, int ldo, int ocol0, float* lse, int hq0) {
    LAS unsigned char* lds = F.lds;
    const int tid = F.tid, lane = F.lane, wave = F.wave, r = lane & 31, h = lane >> 5;
    __syncthreads();
#pragma unroll
    for (int i = 0; i < 4; ++i) {
        const int c = tid + NTHR * i, row = c >> 3, ch = c & 7;
        const int mk = 128 * (cb - 1) + row;
        v4u kv = (v4u){0u, 0u, 0u, 0u}, vv = (v4u){0u, 0u, 0u, 0u};
        if (mk >= 0) { const size_t t = (size_t)mk * dil + rho; kv = *(const GAS v4u*)(QKV + t * ld + kcol + 8 * ch); vv = *(const GAS v4u*)(QKV + t * ld + vcol + 8 * ch); }
        *(LAS v4u*)(lds + AT_K + row * AT_KSTR + ch * 16) = kv;
        *(LAS v4u*)(lds + AT_V + (ch >> 2) * 16384 + row * 64 + (ch & 3) * 16) = vv;
    }
    __syncthreads();
    const int g4 = (lane >> 4) & 1, q4 = (lane & 15) >> 2, p4 = lane & 3;
#pragma unroll 1
    for (int jb = wave; jb < 16; jb += 8) {
        const int qt = jb & 3, rep = jb >> 2;
        const int mq = 128 * cb + 32 * qt + r; const size_t tq = (size_t)mq * dil + rho;
        bf16x8 qf[4];
        { const bf16* qp = QKV + tq * ld + qcol0 + rep * 64 + 8 * h;
#pragma unroll
          for (int ks = 0; ks < 4; ++ks) qf[ks] = *(const GAS bf16x8*)(qp + 16 * ks); }
        f32x16 X[5];
#pragma unroll
        for (int kt = 0; kt < 5; ++kt) {
#pragma unroll
            for (int e = 0; e < 16; ++e) X[kt][e] = 0.f;
#pragma unroll
            for (int ks = 0; ks < 4; ++ks) {
                const bf16x8 kf = *(const LAS bf16x8*)(lds + AT_K + (32 * qt + 32 * kt + r) * AT_KSTR + (16 * ks + 8 * h) * 2);
                X[kt] = MFMA32(kf, qf[ks], X[kt]);
            }
            __builtin_amdgcn_sched_barrier(0);
        }
        const float NEG = -3.0e38f;
        float mx = NEG;
#pragma unroll
        for (int kt = 0; kt < 5; ++kt)
#pragma unroll
            for (int e = 0; e < 16; ++e) {
                const int jw = 32 * kt + crow(e, h), dist = 128 + r - jw;
                const bool ok = (dist >= 0) && (dist <= maxd) && (cb > 0 || (32 * qt + jw) >= 128);
                X[kt][e] = ok ? X[kt][e] : NEG;
                mx = fmaxf(mx, X[kt][e]);
            }
        mx = fmaxf(mx, __shfl_xor(mx, 32));
        float msc = mx * 0.125f; float sk = 0.f;
        if (SINK) { sk = sink4[rep]; msc = fmaxf(msc, sk); }
        const float c1 = 0.125f * 1.4426950408889634f, c2 = msc * 1.4426950408889634f;
        float den = 0.f;
#pragma unroll
        for (int kt = 0; kt < 5; ++kt)
#pragma unroll
            for (int e = 0; e < 16; ++e) { const float p = fexp2(X[kt][e] * c1 - c2); X[kt][e] = p; den += p; }
        den += __shfl_xor(den, 32);
        if (SINK) den += fexp2((sk - msc) * 1.4426950408889634f);
        f32x16 Oa[2];
#pragma unroll
        for (int d = 0; d < 2; ++d)
#pragma unroll
            for (int e = 0; e < 16; ++e) Oa[d][e] = 0.f;
#pragma unroll
        for (int kt = 0; kt < 5; ++kt)
#pragma unroll
            for (int s = 0; s < 2; ++s) {
                const bf16x8 pf = pack8(X[kt][8 * s], X[kt][8 * s + 1], X[kt][8 * s + 2], X[kt][8 * s + 3], X[kt][8 * s + 4], X[kt][8 * s + 5], X[kt][8 * s + 6], X[kt][8 * s + 7]);
                const int krow0 = 32 * qt + 32 * kt + 16 * s + 4 * h + q4;
#pragma unroll
                for (int d = 0; d < 2; ++d) {
                    const LAS unsigned char* vp = lds + AT_V + d * 16384 + krow0 * 64 + 32 * g4 + 8 * p4;
                    const bf16x8 vf = cat8(trr(vp), trr(vp + 8 * 64));
                    Oa[d] = MFMA32(vf, pf, Oa[d]);
                }
                __builtin_amdgcn_sched_barrier(0);
            }
        const float inv = 1.0f / den;
        bf16* op = O + tq * ldo + ocol0 + rep * 64;
#pragma unroll
        for (int d = 0; d < 2; ++d)
#pragma unroll
            for (int rq = 0; rq < 4; ++rq) {
                v2u w; w.x = pk2(Oa[d][4 * rq] * inv, Oa[d][4 * rq + 1] * inv); w.y = pk2(Oa[d][4 * rq + 2] * inv, Oa[d][4 * rq + 3] * inv);
                *(GAS v2u*)(op + 32 * d + 8 * rq + 4 * h) = w;
            }
        if (lse != nullptr && h == 0) lse[tq * 32 + hq0 + rep] = msc + __logf(den);
    }
}

DI void attn_sample_swa_unit(Frame& F, int b, int g) {
    LAS float* Ks = (LAS float*)F.lds;
    LAS float* Vs = Ks + 132 * 65;
    LAS float* Qs = Vs + 132 * 64;
    LAS float* Ps = Qs + 16 * 64;
    const int tid = F.tid;
    const bf16* P1 = (const bf16*)(F.ws + WS_P1);
    const float* ck = F.in[4] + (size_t)b * 128 * 512 + g * 64; const float* cv = F.in[5] + (size_t)b * 128 * 512 + g * 64;
    __syncthreads();
    for (int i = tid; i < 132 * 64; i += NTHR) {
        const int j = i >> 6, d = i & 63; float kk, vv;
        if (j < 128) { kk = ck[(size_t)j * 512 + d]; vv = cv[(size_t)j * 512 + d]; }
        else { const size_t row = (size_t)(MP + 4 * b + (j - 128)) * N1; kk = bflo(P1[row + C_K + g * 64 + d]); vv = bflo(P1[row + C_V + g * 64 + d]); }
        Ks[j * 65 + d] = kk; Vs[j * 64 + d] = vv;
    }
    for (int i = tid; i < 16 * 64; i += NTHR) { const int qr = i >> 6, d = i & 63, rep = qr >> 2, t = qr & 3;
        Qs[i] = bflo(P1[(size_t)(MP + 4 * b + t) * N1 + C_Q + (4 * g + rep) * 64 + d]); }
    __syncthreads();
    const int qr = tid >> 5, ln = tid & 31, rep = qr >> 2, t = qr & 3;
    float sc[5]; float mx = -3.0e38f;
#pragma unroll
    for (int i = 0; i < 5; ++i) {
        const int j = ln + 32 * i; float s = -3.0e38f;
        if (j < 132) {
            const bool ok = j < 128 ? (j > t) : ((j - 128) <= t);
            if (ok) { float a = 0.f;
#pragma unroll 16
                for (int d = 0; d < 64; ++d) a += Qs[qr * 64 + d] * Ks[j * 65 + d];
                s = a * 0.125f; }
        }
        sc[i] = s; mx = fmaxf(mx, s);
    }
#pragma unroll
    for (int o = 1; o < 32; o <<= 1) mx = fmaxf(mx, __shfl_xor(mx, o));
    const float sk = F.in[17][4 * g + rep]; mx = fmaxf(mx, sk);
    float den = 0.f;
#pragma unroll
    for (int i = 0; i < 5; ++i) { const float p = sc[i] > -1.0e38f ? fexp(sc[i] - mx) : 0.f; sc[i] = p; den += p; }
#pragma unroll
    for (int o = 1; o < 32; o <<= 1) den += __shfl_xor(den, o);
    den += fexp(sk - mx);
    const float inv = 1.0f / den;
#pragma unroll
    for (int i = 0; i < 5; ++i) { const int j = ln + 32 * i; if (j < 132) Ps[qr * 136 + j] = sc[i] * inv; }
    __syncthreads();
    float o0 = 0.f, o1 = 0.f;
    for (int j = 0; j < 132; ++j) { const float p = Ps[qr * 136 + j]; o0 += p * Vs[j * 64 + 2 * ln]; o1 += p * Vs[j * 64 + 2 * ln + 1]; }
    bf16* MIX = (bf16*)(F.ws + WS_MIX);
    *(GAS unsigned*)(MIX + (size_t)(MP + 4 * b + t) * KMIX + 2048 + (4 * g + rep) * 64 + 2 * ln) = pk2(o0, o1);
}

constexpr int SD_ROWS = 516, SD_KSTR = 144, SD_K = 0, SD_V = SD_ROWS * SD_KSTR, SD_VH = SD_ROWS * 64, SD_OB = SD_V + 2 * SD_VH, SD_LB = SD_OB + 3 * 16 * 64 * 4;
DI void attn_sample_dil_unit(Frame& F, int b, int g) {
    LAS unsigned char* lds = F.lds;
    LAS float* Ob = (LAS float*)(lds + SD_OB);
    LAS float* Lb = (LAS float*)(lds + SD_LB);
    const int tid = F.tid, wave = F.wave, lane = F.lane, r = lane & 31, h = lane >> 5;
    const bf16* P5 = (const bf16*)(F.ws + WS_P5);
    const float* ck = F.in[6] + (size_t)b * 2048 * 512 + g * 64; const float* cv = F.in[7] + (size_t)b * 2048 * 512 + g * 64;
    const int g4 = (lane >> 4) & 1, q4 = (lane & 15) >> 2, p4 = lane & 3;
#pragma unroll 1
    for (int pass = 0; pass < 2; ++pass) {
        __syncthreads();
#pragma unroll
        for (int it = 0; it < 9; ++it) {
            const int item = tid + NTHR * it;
            if (item < SD_ROWS * 8) {
                const int row = item >> 3, ch = item & 7;
                int off;
                if (pass == 0) off = row - 512; else { const int t = row / 129, k = row - 129 * t; off = t - 16 * k; }
                v4u kq, vq;
                if (off < 0) {
                    const float* kp = ck + (size_t)(2048 + off) * 512 + 8 * ch; const float* vp = cv + (size_t)(2048 + off) * 512 + 8 * ch;
                    const f32x4 k0 = *(const GAS f32x4*)kp, k1 = *(const GAS f32x4*)(kp + 4), v0 = *(const GAS f32x4*)vp, v1 = *(const GAS f32x4*)(vp + 4);
                    kq.x = pk2(k0[0], k0[1]); kq.y = pk2(k0[2], k0[3]); kq.z = pk2(k1[0], k1[1]); kq.w = pk2(k1[2], k1[3]);
                    vq.x = pk2(v0[0], v0[1]); vq.y = pk2(v0[2], v0[3]); vq.z = pk2(v1[0], v1[1]); vq.w = pk2(v1[2], v1[3]);
                } else {
                    const bf16* rp = P5 + (size_t)(MP + 4 * b + off) * N5 + g * 64 + 8 * ch;
                    kq = *(const GAS v4u*)(rp + O_K); vq = *(const GAS v4u*)(rp + O_V);
                }
                *(LAS v4u*)(lds + SD_K + row * SD_KSTR + ch * 16) = kq;
                *(LAS v4u*)(lds + SD_V + (ch >> 2) * SD_VH + row * 64 + (ch & 3) * 16) = vq;
            }
        }
        __syncthreads();
        if (pass == 0 || wave < 4) {
            const int pat = pass == 0 ? (wave >> 2) : 2, t = wave & 3;
            auto rowof = [&](int k) -> int { k = k > 128 ? 128 : k; return pass == 0 ? (512 + t - (pat == 0 ? k : 4 * k)) : (129 * t + k); };
            bf16x8 qf[4];
            { const bf16* qp = P5 + (size_t)(MP + 4 * b + t) * N5 + pat * 2048 + (4 * g + (r & 3)) * 64 + 8 * h;
#pragma unroll
              for (int ks = 0; ks < 4; ++ks) qf[ks] = *(const GAS bf16x8*)(qp + 16 * ks); }
            f32x16 X[5];
#pragma unroll
            for (int kt = 0; kt < 5; ++kt) {
#pragma unroll
                for (int e = 0; e < 16; ++e) X[kt][e] = 0.f;
                const int krow = rowof(32 * kt + r);
#pragma unroll
                for (int ks = 0; ks < 4; ++ks) {
                    const bf16x8 kf = *(const LAS bf16x8*)(lds + SD_K + krow * SD_KSTR + (16 * ks + 8 * h) * 2);
                    X[kt] = MFMA32(kf, qf[ks], X[kt]);
                }
                __builtin_amdgcn_sched_barrier(0);
            }
            const float NEG = -3.0e38f;
            float mx = NEG;
#pragma unroll
            for (int kt = 0; kt < 5; ++kt)
#pragma unroll
                for (int e = 0; e < 16; ++e) { const bool ok = (32 * kt + crow(e, h)) <= 128; X[kt][e] = ok ? X[kt][e] : NEG; mx = fmaxf(mx, X[kt][e]); }
            mx = fmaxf(mx, __shfl_xor(mx, 32));
            const float msc = mx * 0.125f, c1 = 0.125f * 1.4426950408889634f, c2 = msc * 1.4426950408889634f;
            float den = 0.f;
#pragma unroll
            for (int kt = 0; kt < 5; ++kt)
#pragma unroll
                for (int e = 0; e < 16; ++e) { const float p = fexp2(X[kt][e] * c1 - c2); X[kt][e] = p; den += p; }
            den += __shfl_xor(den, 32);
            f32x16 Oa[2];
#pragma unroll
            for (int d = 0; d < 2; ++d)
#pragma unroll
                for (int e = 0; e < 16; ++e) Oa[d][e] = 0.f;
#pragma unroll
            for (int kt = 0; kt < 5; ++kt)
#pragma unroll
                for (int s2 = 0; s2 < 2; ++s2) {
                    const bf16x8 pf = pack8(X[kt][8 * s2], X[kt][8 * s2 + 1], X[kt][8 * s2 + 2], X[kt][8 * s2 + 3], X[kt][8 * s2 + 4], X[kt][8 * s2 + 5], X[kt][8 * s2 + 6], X[kt][8 * s2 + 7]);
                    const int k0 = 32 * kt + 16 * s2 + 4 * h + q4;
                    const int ra = rowof(k0), rb = rowof(k0 + 8);
#pragma unroll
                    for (int d = 0; d < 2; ++d) {
                        const LAS unsigned char* vb = lds + SD_V + d * SD_VH + 32 * g4 + 8 * p4;
                        const bf16x8 vf = cat8(trr(vb + ra * 64), trr(vb + rb * 64));
                        Oa[d] = MFMA32(vf, pf, Oa[d]);
                    }
                    __builtin_amdgcn_sched_barrier(0);
                }
            if (r < 4) {
                const float inv = 1.0f / den;
                LAS float* ob = Ob + ((pat * 4 + t) * 4 + r) * 64;
#pragma unroll
                for (int d = 0; d < 2; ++d)
#pragma unroll
                    for (int e = 0; e < 16; ++e) ob[32 * d + crow(e, h)] = Oa[d][e] * inv;
                if (h == 0) Lb[(pat * 4 + t) * 4 + r] = msc + __logf(den);
            }
        }
    }
    __syncthreads();
    bf16* MRG = (bf16*)(F.ws + WS_MRG);
    { const int i = tid * 2;
        const int d = i & 63, rep = (i >> 6) & 3, t = i >> 8;
        const float l0 = Lb[(0 * 4 + t) * 4 + rep], l1 = Lb[(1 * 4 + t) * 4 + rep], l2 = Lb[(2 * 4 + t) * 4 + rep];
        const float lm = fmaxf(l0, fmaxf(l1, l2)); float w0 = fexp(l0 - lm), w1 = fexp(l1 - lm), w2 = fexp(l2 - lm);
        const float inv = 1.0f / (w0 + w1 + w2); w0 *= inv; w1 *= inv; w2 *= inv;
        const LAS float* o0 = Ob + ((0 * 4 + t) * 4 + rep) * 64 + d; const LAS float* o1 = Ob + ((1 * 4 + t) * 4 + rep) * 64 + d; const LAS float* o2 = Ob + ((2 * 4 + t) * 4 + rep) * 64 + d;
        *(GAS unsigned*)(MRG + (size_t)(MP + 4 * b + t) * DM + (4 * g + rep) * 64 + d) = pk2(w0 * o0[0] + w1 * o1[0] + w2 * o2[0], w0 * o0[1] + w1 * o1[1] + w2 * o2[1]);
    }
}

DI void ssd_dt_scan(Frame& F, int t0, int head, float& dt0, float& dt1, float& acs0, float& acs1, float& total) {
    const float* DT = (const float*)(F.ws + WS_DT);
    const float bias = F.in[13][head], a = -__expf(F.in[14][head]);
    const int l = 2 * F.lane;
    dt0 = softplusf_(DT[(size_t)(t0 + l) * 32 + head] + bias); dt1 = softplusf_(DT[(size_t)(t0 + l + 1) * 32 + head] + bias);
    const float la0 = dt0 * a, la1 = dt1 * a;
    float s = la0 + la1;
#pragma unroll
    for (int o = 1; o < 64; o <<= 1) { const float v = __shfl_up(s, o); if (F.lane >= o) s += v; }
    acs1 = s; acs0 = s - la1; total = __shfl(s, 63);
}

template <class Sink>
DI void conv_task(Frame& F, int t0, int l0, int chabs, const Sink& sink) {
    const bf16* P1 = (const bf16*)(F.ws + WS_P1);
    const float* cw = F.in[11]; const float* cbias = F.in[12];
    float w[4][8], bs[8];
#pragma unroll
    for (int i = 0; i < 4; ++i) { const f32x4 a = *(const f32x4*)(cw + i * CONVD + chabs), b = *(const f32x4*)(cw + i * CONVD + chabs + 4);
        w[i][0] = a[0]; w[i][1] = a[1]; w[i][2] = a[2]; w[i][3] = a[3]; w[i][4] = b[0]; w[i][5] = b[1]; w[i][6] = b[2]; w[i][7] = b[3]; }
    { const f32x4 a = *(const f32x4*)(cbias + chabs), b = *(const f32x4*)(cbias + chabs + 4); bs[0] = a[0]; bs[1] = a[1]; bs[2] = a[2]; bs[3] = a[3]; bs[4] = b[0]; bs[5] = b[1]; bs[6] = b[2]; bs[7] = b[3]; }
    float hst[3][8];
#pragma unroll
    for (int i = 0; i < 3; ++i) {
        const int t = t0 + l0 - 3 + i; v4u u = (v4u){0u, 0u, 0u, 0u};
        if (t >= 0) u = *(const GAS v4u*)(P1 + (size_t)t * N1 + C_XBC + chabs);
        hst[i][0] = bflo(u.x); hst[i][1] = bfhi(u.x); hst[i][2] = bflo(u.y); hst[i][3] = bfhi(u.y); hst[i][4] = bflo(u.z); hst[i][5] = bfhi(u.z); hst[i][6] = bflo(u.w); hst[i][7] = bfhi(u.w);
    }
#pragma unroll
    for (int i = 0; i < 16; ++i) {
        const v4u u = *(const GAS v4u*)(P1 + (size_t)(t0 + l0 + i) * N1 + C_XBC + chabs);
        float cur[8] = {bflo(u.x), bfhi(u.x), bflo(u.y), bfhi(u.y), bflo(u.z), bfhi(u.z), bflo(u.w), bfhi(u.w)};
        float o[8];
#pragma unroll
        for (int j = 0; j < 8; ++j) { const float a = bs[j] + w[0][j] * hst[0][j] + w[1][j] * hst[1][j] + w[2][j] * hst[2][j] + w[3][j] * cur[j]; o[j] = siluf_(a);
            hst[0][j] = hst[1][j]; hst[1][j] = hst[2][j]; hst[2][j] = cur[j]; }
        sink(l0 + i, o);
    }
}

constexpr int SA_W = 0, SA_B = 8192, SA_BSTR = 320, SA_X = SA_B + 128 * SA_BSTR, SA_XSTR = 576;
DI void ssd_a_unit(Frame& F, int c, int g) {
    LAS unsigned char* lds = F.lds;
    LAS float* Wl = (LAS float*)(lds + SA_W);
    const int tid = F.tid, lane = F.lane, wave = F.wave, r = lane & 31, h = lane >> 5, t0 = 128 * c;
    bf16* XC = (bf16*)(F.ws + WS_XC); float* ST = (float*)(F.ws + WS_ST); float* CD = (float*)(F.ws + WS_CD);
    __syncthreads();
    { float dt0, dt1, a0, a1, tot; ssd_dt_scan(F, t0, 8 * g + wave, dt0, dt1, a0, a1, tot);
      Wl[wave * 128 + 2 * lane] = dt0 * __expf(tot - a0); Wl[wave * 128 + 2 * lane + 1] = dt1 * __expf(tot - a1);
      if (lane == 63) CD[c * 32 + 8 * g + wave] = __expf(tot); }
    __syncthreads();
    const int g4 = (lane >> 4) & 1, q4 = (lane & 15) >> 2, p4 = lane & 3;
#pragma unroll 1
    for (int half = 0; half < 2; ++half) {
        if (half == 0 || tid < 256) {
            int oct, run; if (half == 0) { oct = tid & 63; run = tid >> 6; } else { oct = 32 + (tid & 31); run = tid >> 5; }
            int chabs, kind, lcol, hh = 0;
            if (oct < 16) { kind = 0; chabs = 2048 + 128 * g + 8 * oct; lcol = 8 * oct; }
            else if (oct < 32) { kind = 1; chabs = 2560 + 128 * g + 8 * (oct - 16); lcol = 0; }
            else { kind = 2; const int idx = oct - 32, hl = idx >> 3; hh = 4 * half + hl; chabs = 512 * g + 64 * hh + 8 * (idx & 7); lcol = 64 * hl + 8 * (idx & 7); }
            conv_task(F, t0, 16 * run, chabs, [&](int l, const float (&o)[8]) {
                v4u pkd; pkd.x = pk2(o[0], o[1]); pkd.y = pk2(o[2], o[3]); pkd.z = pk2(o[4], o[5]); pkd.w = pk2(o[6], o[7]);
                *(GAS v4u*)(XC + (size_t)(t0 + l) * CONVD + chabs) = pkd;
                if (kind == 0) *(LAS v4u*)(lds + SA_B + l * SA_BSTR + lcol * 2) = pkd;
                else if (kind == 2) { const float wv = Wl[hh * 128 + l]; v4u s; s.x = pk2(o[0] * wv, o[1] * wv); s.y = pk2(o[2] * wv, o[3] * wv); s.z = pk2(o[4] * wv, o[5] * wv); s.w = pk2(o[6] * wv, o[7] * wv);
                    *(LAS v4u*)(lds + SA_X + l * SA_XSTR + lcol * 2) = s; }
            });
        }
        __syncthreads();
        { const int hl = wave >> 1, pt = wave & 1, head = 8 * g + 4 * half + hl;
          f32x16 acc[4];
#pragma unroll
          for (int nt = 0; nt < 4; ++nt)
#pragma unroll
              for (int e = 0; e < 16; ++e) acc[nt][e] = 0.f;
#pragma unroll
          for (int ks = 0; ks < 8; ++ks) {
              const int lrow = 16 * ks + 8 * h + q4;
              const LAS unsigned char* ap = lds + SA_X + lrow * SA_XSTR + (64 * hl + 32 * pt + 16 * g4 + 4 * p4) * 2;
              const bf16x8 af = cat8(trr(ap), trr(ap + 4 * SA_XSTR));
#pragma unroll
              for (int nt = 0; nt < 4; ++nt) {
                  const LAS unsigned char* bp = lds + SA_B + lrow * SA_BSTR + (32 * nt + 16 * g4 + 4 * p4) * 2;
                  const bf16x8 bfr = cat8(trr(bp), trr(bp + 4 * SA_BSTR));
                  acc[nt] = MFMA32(af, bfr, acc[nt]);
              }
          }
          float* sp = ST + ((size_t)(c * 32 + head) * 64) * 128;
#pragma unroll
          for (int nt = 0; nt < 4; ++nt)
#pragma unroll
              for (int e = 0; e < 16; ++e) sp[(size_t)(32 * pt + crow(e, h)) * 128 + 32 * nt + r] = acc[nt][e];
        }
        __syncthreads();
    }
}

DI void ssd_carry_phase(Frame& F) {
    const float* ST = (const float*)(F.ws + WS_ST); const float* CD = (const float*)(F.ws + WS_CD); bf16* HIN = (bf16*)(F.ws + WS_HIN);
    for (int gt = F.bid * NTHR + F.tid; gt < 131072; gt += F.G * NTHR) {
        const int e = 2 * gt, head = e >> 13;
        f32x2 hs = {0.f, 0.f};
#pragma unroll 1
        for (int c0 = 0; c0 < 64; c0 += 16) {
            f32x2 s[16]; float dc[16];
#pragma unroll
            for (int i = 0; i < 16; ++i) { s[i] = *(const GAS f32x2*)(ST + (size_t)(c0 + i) * 262144 + e); dc[i] = CD[(c0 + i) * 32 + head]; }
#pragma unroll
            for (int i = 0; i < 16; ++i) { *(GAS unsigned*)(HIN + (size_t)(c0 + i) * 262144 + e) = pk2(hs.x, hs.y); hs = hs * dc[i] + s[i]; }
        }
        *(GAS f32x2*)(F.out + OUT_PSSM + e) = hs;
    }
}

constexpr int SC_ACS = 0, SC_DT = 4096, SC_B = 8192, SC_STR = 272, SC_C = SC_B + 128 * SC_STR, SC_X = SC_C + 128 * SC_STR, SC_XSTR = 192, SC_H = SC_X + 128 * SC_XSTR, SC_SSQ = SC_H + 64 * SC_STR;
DI void ssd_c_unit(Frame& F, int c, int g) {
    LAS unsigned char* lds = F.lds;
    LAS float* ACS = (LAS float*)(lds + SC_ACS); LAS float* DTV = (LAS float*)(lds + SC_DT); LAS float* SSQ = (LAS float*)(lds + SC_SSQ);
    const int tid = F.tid, lane = F.lane, wave = F.wave, r = lane & 31, h = lane >> 5, t0 = 128 * c;
    const bf16* XC = (const bf16*)(F.ws + WS_XC); const bf16* HIN = (const bf16*)(F.ws + WS_HIN); const bf16* P1 = (const bf16*)(F.ws + WS_P1); bf16* MIX = (bf16*)(F.ws + WS_MIX);
    __syncthreads();
    { float dt0, dt1, a0, a1, tot; ssd_dt_scan(F, t0, 8 * g + wave, dt0, dt1, a0, a1, tot);
      ACS[wave * 128 + 2 * lane] = a0; ACS[wave * 128 + 2 * lane + 1] = a1; DTV[wave * 128 + 2 * lane] = dt0; DTV[wave * 128 + 2 * lane + 1] = dt1; }
#pragma unroll
    for (int i = 0; i < 4; ++i) { const int cc = tid + NTHR * i, row = cc >> 4, ch = cc & 15;
        *(LAS v4u*)(lds + SC_B + row * SC_STR + ch * 16) = *(const GAS v4u*)(XC + (size_t)(t0 + row) * CONVD + 2048 + 128 * g + 8 * ch);
        *(LAS v4u*)(lds + SC_C + row * SC_STR + ch * 16) = *(const GAS v4u*)(XC + (size_t)(t0 + row) * CONVD + 2560 + 128 * g + 8 * ch); }
    __syncthreads();
    const int lt = wave >> 1, pt = wave & 1, l = 32 * lt + r;
    const int g4 = (lane >> 4) & 1, q4 = (lane & 15) >> 2, p4 = lane & 3;
    const LAS unsigned char* cfp = lds + SC_C + l * SC_STR + 16 * h;
    unsigned Xp[4][8];
#pragma unroll
    for (int st = 0; st < 4; ++st) {
#pragma unroll
        for (int e = 0; e < 8; ++e) Xp[st][e] = 0u;
        if (st <= lt) {
            f32x16 X;
#pragma unroll
            for (int e = 0; e < 16; ++e) X[e] = 0.f;
#pragma unroll
            for (int ks = 0; ks < 8; ++ks) { const bf16x8 bfr = *(const LAS bf16x8*)(lds + SC_B + (32 * st + r) * SC_STR + (16 * ks + 8 * h) * 2); const bf16x8 cf = *(const LAS bf16x8*)(cfp + 32 * ks); X = MFMA32(bfr, cf, X); }
#pragma unroll
            for (int e = 0; e < 8; ++e) Xp[st][e] = pk2(X[2 * e], X[2 * e + 1]);
        }
    }
    float ssq = 0.f;
    bf16* myrow = MIX + (size_t)(t0 + l) * KMIX + 512 * g + 32 * pt + 4 * h;
#pragma unroll 1
    for (int hh = 0; hh < 8; ++hh) {
        const int head = 8 * g + hh;
        __syncthreads();
#pragma unroll
        for (int i = 0; i < 2; ++i) { const int cc = tid + NTHR * i;
            { const int row = cc >> 3, ch = cc & 7; *(LAS v4u*)(lds + SC_X + row * SC_XSTR + ch * 16) = *(const GAS v4u*)(XC + (size_t)(t0 + row) * CONVD + 512 * g + 64 * hh + 8 * ch); }
            { const int row = cc >> 4, ch = cc & 15; *(LAS v4u*)(lds + SC_H + row * SC_STR + ch * 16) = *(const GAS v4u*)(HIN + ((size_t)(c * 32 + head) * 64 + row) * 128 + 8 * ch); } }
        __syncthreads();
        f32x16 acc;
#pragma unroll
        for (int e = 0; e < 16; ++e) acc[e] = 0.f;
#pragma unroll
        for (int ks = 0; ks < 8; ++ks) { const bf16x8 hf = *(const LAS bf16x8*)(lds + SC_H + (32 * pt + r) * SC_STR + (16 * ks + 8 * h) * 2); const bf16x8 cf = *(const LAS bf16x8*)(cfp + 32 * ks); acc = MFMA32(hf, cf, acc); }
        const float al = ACS[hh * 128 + l], el = __expf(al);
#pragma unroll
        for (int e = 0; e < 16; ++e) acc[e] *= el;
#pragma unroll
        for (int st = 0; st < 4; ++st) {
            if (st <= lt) {
#pragma unroll
                for (int ss = 0; ss < 2; ++ss) {
                    float mv[8];
#pragma unroll
                    for (int j = 0; j < 8; ++j) {
                        const int e = 8 * ss + j, sl = crow(e, h), s = 32 * st + sl;
                        const float cb = (e & 1) ? bfhi(Xp[st][e >> 1]) : bflo(Xp[st][e >> 1]);
                        const float dec = __expf(al - ACS[hh * 128 + s]) * DTV[hh * 128 + s];
                        mv[j] = (st < lt || sl <= r) ? cb * dec : 0.f;
                    }
                    const bf16x8 mf = pack8(mv[0], mv[1], mv[2], mv[3], mv[4], mv[5], mv[6], mv[7]);
                    const LAS unsigned char* xp = lds + SC_X + (32 * st + 16 * ss + 4 * h + q4) * SC_XSTR + (32 * pt + 16 * g4 + 4 * p4) * 2;
                    const bf16x8 xf = cat8(trr(xp), trr(xp + 8 * SC_XSTR));
                    acc = MFMA32(xf, mf, acc);
                }
            }
        }
        const float dsk = F.in[15][head];
#pragma unroll
        for (int rq = 0; rq < 4; ++rq) {
            const int p0 = 32 * pt + 8 * rq + 4 * h;
            const v2u xx = *(const LAS v2u*)(lds + SC_X + l * SC_XSTR + p0 * 2);
            const v2u zz = *(const GAS v2u*)(P1 + (size_t)(t0 + l) * N1 + C_Z + 512 * g + 64 * hh + p0);
            const float xv[4] = {bflo(xx.x), bfhi(xx.x), bflo(xx.y), bfhi(xx.y)}, zv[4] = {bflo(zz.x), bfhi(zz.x), bflo(zz.y), bfhi(zz.y)};
            float y[4];
#pragma unroll
            for (int e = 0; e < 4; ++e) { y[e] = (acc[4 * rq + e] + dsk * xv[e]) * siluf_(zv[e]); ssq += y[e] * y[e]; }
            v2u w; w.x = pk2(y[0], y[1]); w.y = pk2(y[2], y[3]);
            *(GAS v2u*)(myrow + 64 * hh + 8 * rq) = w;
        }
    }
    ssq += __shfl_xor(ssq, 32);
    if (h == 0) SSQ[pt * 128 + l] = ssq;
    asm volatile("s_waitcnt vmcnt(0)" ::: "memory");
    __syncthreads();
    const float rstd = 1.0f / sqrtf((SSQ[l] + SSQ[128 + l]) * (1.f / 512.f) + EPS);
    const float* gn = F.in[16] + 512 * g + 32 * pt + 4 * h;
#pragma unroll 1
    for (int hh = 0; hh < 8; ++hh)
#pragma unroll
        for (int rq = 0; rq < 4; ++rq) {
            const f32x4 gg = *(const f32x4*)(gn + 64 * hh + 8 * rq);
            const v2u yy = __builtin_nontemporal_load((const GAS v2u*)(myrow + 64 * hh + 8 * rq));
            v2u w; w.x = pk2(bflo(yy.x) * rstd * gg[0], bfhi(yy.x) * rstd * gg[1]); w.y = pk2(bflo(yy.y) * rstd * gg[2], bfhi(yy.y) * rstd * gg[3]);
            *(GAS v2u*)(myrow + 64 * hh + 8 * rq) = w;
        }
}

DI void ssd_sample_unit(Frame& F, int b, int g) {
    LAS float* xc = (LAS float*)F.lds;
    LAS float* dtv = xc + 4 * 768;
    LAS float* dav = dtv + 32;
    LAS float* ys = dav + 32;
    LAS float* rs = ys + 4 * 512;
    const int tid = F.tid, lane = F.lane, wave = F.wave;
    const bf16* P1 = (const bf16*)(F.ws + WS_P1); const float* DT = (const float*)(F.ws + WS_DT); bf16* MIX = (bf16*)(F.ws + WS_MIX);
    const size_t row0 = (size_t)MP + 4 * b;
    __syncthreads();
    for (int ch = tid; ch < 768; ch += NTHR) {
        const int chabs = ch < 512 ? 512 * g + ch : (ch < 640 ? 2048 + 128 * g + (ch - 512) : 2560 + 128 * g + (ch - 640));
        float xp[7];
#pragma unroll
        for (int i = 0; i < 3; ++i) xp[i] = F.in[2][((size_t)b * 3 + i) * CONVD + chabs];
#pragma unroll
        for (int t = 0; t < 4; ++t) xp[3 + t] = bflo(P1[(row0 + t) * N1 + C_XBC + chabs]);
        const float w0 = F.in[11][chabs], w1 = F.in[11][CONVD + chabs], w2 = F.in[11][2 * CONVD + chabs], w3 = F.in[11][3 * CONVD + chabs], bb = F.in[12][chabs];
#pragma unroll
        for (int t = 0; t < 4; ++t) xc[t * 768 + ch] = siluf_(bb + w0 * xp[t] + w1 * xp[t + 1] + w2 * xp[t + 2] + w3 * xp[t + 3]);
    }
    if (tid < 32) { const int t = tid >> 3, hh = tid & 7, head = 8 * g + hh;
        const float dt = softplusf_(DT[(row0 + t) * 32 + head] + F.in[13][head]); dtv[tid] = dt; dav[tid] = __expf(dt * -__expf(F.in[14][head])); }
    __syncthreads();
    const int p = tid >> 3, ns = (tid & 7) * 16;
#pragma unroll 1
    for (int hh = 0; hh < 8; ++hh) {
        const int head = 8 * g + hh;
        const float* hp = F.in[3] + (((size_t)b * 32 + head) * 64 + p) * 128 + ns;
        float hv[16];
#pragma unroll
        for (int i = 0; i < 4; ++i) { const f32x4 v = *(const GAS f32x4*)(hp + 4 * i); hv[4 * i] = v[0]; hv[4 * i + 1] = v[1]; hv[4 * i + 2] = v[2]; hv[4 * i + 3] = v[3]; }
        const float dsk = F.in[15][head];
#pragma unroll
        for (int t = 0; t < 4; ++t) {
            const float da = dav[t * 8 + hh], xv = xc[t * 768 + 64 * hh + p], coef = dtv[t * 8 + hh] * xv;
            float part = 0.f;
#pragma unroll
            for (int i = 0; i < 16; ++i) { hv[i] = hv[i] * da + coef * xc[t * 768 + 512 + ns + i]; part += hv[i] * xc[t * 768 + 640 + ns + i]; }
            part += __shfl_xor(part, 1); part += __shfl_xor(part, 2); part += __shfl_xor(part, 4);
            if ((tid & 7) == 0) { const float z = bflo(P1[(row0 + t) * N1 + C_Z + 512 * g + 64 * hh + p]); ys[t * 512 + 64 * hh + p] = (part + dsk * xv) * siluf_(z); }
        }
        float* op = F.out + OUT_SSSM + (((size_t)b * 32 + head) * 64 + p) * 128 + ns;
#pragma unroll
        for (int i = 0; i < 4; ++i) *(GAS f32x4*)(op + 4 * i) = (f32x4){hv[4 * i], hv[4 * i + 1], hv[4 * i + 2], hv[4 * i + 3]};
    }
    __syncthreads();
    if (wave < 4) { float s = 0.f;
#pragma unroll
        for (int i = 0; i < 8; ++i) { const float v = ys[wave * 512 + lane + 64 * i]; s += v * v; }
        s = wave_sum(s); if (lane == 0) rs[wave] = 1.0f / sqrtf(s * (1.f / 512.f) + EPS); }
    __syncthreads();
    for (int i = tid; i < 4 * 256; i += NTHR) { const int t = i >> 8, cp = (i & 255) * 2; const float rr = rs[t];
        *(GAS unsigned*)(MIX + (row0 + t) * KMIX + 512 * g + cp) = pk2(ys[t * 512 + cp] * rr * F.in[16][512 * g + cp], ys[t * 512 + cp + 1] * rr * F.in[16][512 * g + cp + 1]); }
}

DI void merge_phase(Frame& F) {
    const bf16* O3 = (const bf16*)(F.ws + WS_O3); const float* LSE = (const float*)(F.ws + WS_LSE); bf16* MRG = (bf16*)(F.ws + WS_MRG);
    for (int i = F.bid * NTHR + F.tid; i < MP * 32 * 8; i += F.G * NTHR) {
        const int d8 = i & 7, hq = (i >> 3) & 31, t = i >> 8;
        const float l0 = LSE[(size_t)t * 32 + hq], l1 = LSE[(size_t)MROWS * 32 + (size_t)t * 32 + hq], l2 = LSE[(size_t)2 * MROWS * 32 + (size_t)t * 32 + hq];
        const float lm = fmaxf(l0, fmaxf(l1, l2)); float w0 = fexp(l0 - lm), w1 = fexp(l1 - lm), w2 = fexp(l2 - lm);
        const float inv = 1.0f / (w0 + w1 + w2); w0 *= inv; w1 *= inv; w2 *= inv;
        const size_t off = (size_t)t * DM + hq * 64 + d8 * 8;
        const v4u a = *(const GAS v4u*)(O3 + off), b = *(const GAS v4u*)(O3 + (size_t)MROWS * DM + off), c = *(const GAS v4u*)(O3 + (size_t)2 * MROWS * DM + off);
        v4u o;
        o.x = pk2(w0 * bflo(a.x) + w1 * bflo(b.x) + w2 * bflo(c.x), w0 * bfhi(a.x) + w1 * bfhi(b.x) + w2 * bfhi(c.x));
        o.y = pk2(w0 * bflo(a.y) + w1 * bflo(b.y) + w2 * bflo(c.y), w0 * bfhi(a.y) + w1 * bfhi(b.y) + w2 * bfhi(c.y));
        o.z = pk2(w0 * bflo(a.z) + w1 * bflo(b.z) + w2 * bflo(c.z), w0 * bfhi(a.z) + w1 * bfhi(b.z) + w2 * bfhi(c.z));
        o.w = pk2(w0 * bflo(a.w) + w1 * bflo(b.w) + w2 * bflo(c.w), w0 * bfhi(a.w) + w1 * bfhi(b.w) + w2 * bfhi(c.w));
        *(GAS v4u*)(MRG + off) = o;
    }
}

struct Args { const float* in[24]; float* out; unsigned char* ws; int ph_lo, ph_hi; };
__global__ void __launch_bounds__(NTHR, 2) mega_fwd(Args args) {
    extern __shared__ __attribute__((aligned(16))) unsigned char lds_raw[];
    Frame F;
    F.lds = (LAS unsigned char*)lds_raw;
    F.tid = threadIdx.x; F.lane = F.tid & 63; F.wave = __builtin_amdgcn_readfirstlane(F.tid >> 6);
    F.G = gridDim.x; F.bid = blockIdx.x;
    F.in = args.in;
    F.out = args.out; F.ws = args.ws;
    volatile LAS unsigned* MISC = (volatile LAS unsigned*)(F.lds + MISC_OFF);
    if (F.tid < 64) MISC[F.tid] = 0u;
    __syncthreads();
    gu32* ctl = (gu32*)(F.ws + WS_CTL);
#if MK_ONE_LAUNCH
    XcdBarrier bar = xcd_barrier_post((unsigned*)(ctl + CW_BAR), MISC + 8);
#define GRID_BAR() xcd_barrier(bar)
#else
#define GRID_BAR() do { } while (0)
#endif
    const int lo = args.ph_lo, hi = args.ph_hi;
#ifndef PH_MASK
#define PH_MASK 0x3ffff
#endif
#define IN(k) ((((PH_MASK) >> (k)) & 1) && lo <= (k) && (k) < hi)
#ifndef PROBE_DUP
#define PROBE_DUP -1
#endif
#define REPS(k) for (int rep_ = 0; rep_ < ((k) == PROBE_DUP ? 2 : 1); ++rep_)
#define SEAM(k) do { if (IN(k) && IN((k) + 1)) GRID_BAR(); } while (0)
    unsigned char* ws = F.ws;
    bf16* XN = (bf16*)(ws + WS_XN); bf16* P1 = (bf16*)(ws + WS_P1); bf16* MIX = (bf16*)(ws + WS_MIX); float* H = (float*)(ws + WS_H); bf16* U = (bf16*)(ws + WS_U);
    bf16* P5 = (bf16*)(ws + WS_P5); bf16* O3 = (bf16*)(ws + WS_O3); bf16* MRG = (bf16*)(ws + WS_MRG); float* LSE = (float*)(ws + WS_LSE);
    const float* rope = (const float*)(ws + WS_ROPE);
    using pg8::Gemm; using pg8::StaticOrder;

    if (IN(0)) REPS(0) { p0_prologue(F); } SEAM(0);
    if (IN(1)) REPS(1) { Gemm g{XN, (const bf16*)(ws + WS_W1T), MROWS, N1, DM}; StaticOrder S; S.init(MROWS, N1, F.G, F.bid, DM);
        pg8::EpiProj1 E{P1, (float*)(ws + WS_DT), rope, F.out};
        pg8::gemm_phase<pg8::EpiProj1, StaticOrder, true, true>(F.lds, g, S, E); } SEAM(1);
    if (IN(2)) REPS(2) {
        REPS(20) for (int u = F.bid; u < 256; u += F.G) ssd_a_unit(F, u >> 2, u & 3);
        REPS(21) for (int u = F.bid; u < 512; u += F.G) { const int qb = u >> 3, g = u & 7;
            attn_prompt_unit<true>(F, P1, N1, C_Q + g * 256, C_K + g * 64, C_V + g * 64, 1, 0, qb, 127, F.in[17] + 4 * g, MIX, KMIX, 2048 + g * 256, nullptr, 0); }
        REPS(22) for (int u = F.bid; u < 512; u += F.G) ssd_sample_unit(F, u >> 2, u & 3);
        REPS(23) for (int u = F.bid; u < 1024; u += F.G) attn_sample_swa_unit(F, u >> 3, u & 7);
    } SEAM(2);
    if (IN(3)) REPS(3) { ssd_carry_phase(F); } SEAM(3);
    if (IN(4)) REPS(4) { for (int u = F.bid; u < 256; u += F.G) ssd_c_unit(F, u >> 2, u & 3); } SEAM(4);
    if (IN(5)) REPS(5) { __syncthreads(); Gemm g{MIX, (const bf16*)(ws + WS_W2T), MROWS, DM, KMIX}; pg8::SplitOrder S; S.init(F.G, F.bid, KMIX);
        pg8::EpiRes E{F.in[0], H, (float*)(ws + WS_PART)};
        pg8::gemm_phase<pg8::EpiRes, pg8::SplitOrder, true, true>(F.lds, g, S, E); } SEAM(5);
    if (IN(6)) REPS(6) { norm_phase(F, H, H + (size_t)MP * DM, F.in[9], XN, true); } SEAM(6);
    if (IN(7)) REPS(7) { Gemm g{XN, (const bf16*)(ws + WS_WM1T), MROWS, FF, DM}; StaticOrder S; S.init(MROWS, FF, F.G, F.bid, DM);
        pg8::EpiSq E{U};
        pg8::gemm_phase<pg8::EpiSq, StaticOrder, true, true>(F.lds, g, S, E); } SEAM(7);
    if (IN(8)) REPS(8) { Gemm g{U, (const bf16*)(ws + WS_WM2T), MROWS, DM, FF}; pg8::SplitOrder S; S.init(F.G, F.bid, FF);
        pg8::EpiRes E{H, H, (float*)(ws + WS_PART)};
        pg8::gemm_phase<pg8::EpiRes, pg8::SplitOrder, true, true>(F.lds, g, S, E); } SEAM(8);
    if (IN(9)) REPS(9) { norm_phase(F, H, H + (size_t)MP * DM, F.in[8] + DM, XN, true); } SEAM(9);
    if (IN(10)) REPS(10) { Gemm g{XN, (const bf16*)(ws + WS_W5T), MROWS, N5, DM}; StaticOrder S; S.init(MROWS, N5, F.G, F.bid, DM);
        pg8::EpiProj5 E{P5, rope, F.out};
        pg8::gemm_phase<pg8::EpiProj5, StaticOrder, true, true>(F.lds, g, S, E); } SEAM(10);
    if (IN(11)) REPS(11) {
        REPS(110) for (int u = F.bid; u < 1536; u += F.G) { const int pat = u >> 9, v = u & 511, blk = v >> 3, g = v & 7;
            const int dil = pat == 0 ? 1 : (pat == 1 ? 4 : 16), nb = 64 / dil, rho = blk / nb, cb = blk % nb;
            attn_prompt_unit<false>(F, P5, N5, pat * 2048 + g * 256, O_K + g * 64, O_V + g * 64, dil, rho, cb, 128, nullptr, O3 + (size_t)pat * MROWS * DM, DM, g * 256, LSE + (size_t)pat * MROWS * 32, 4 * g); }
        REPS(111) for (int u = F.bid; u < 1024; u += F.G) attn_sample_dil_unit(F, u >> 3, u & 7);
    } SEAM(11);
    if (IN(12)) REPS(12) { merge_phase(F); } SEAM(12);
    if (IN(13)) REPS(13) { __syncthreads(); Gemm g{MRG, (const bf16*)(ws + WS_W6T), MROWS, DM, DM}; pg8::SplitOrder S; S.init(F.G, F.bid, DM);
        pg8::EpiRes E{H, H, (float*)(ws + WS_PART)};
        pg8::gemm_phase<pg8::EpiRes, pg8::SplitOrder, true, true>(F.lds, g, S, E); } SEAM(13);
    if (IN(14)) REPS(14) { norm_phase(F, H, H + (size_t)MP * DM, F.in[9] + DM, XN, true); } SEAM(14);
    if (IN(15)) REPS(15) { Gemm g{XN, (const bf16*)(ws + WS_WM1T) + (size_t)FF * DM, MROWS, FF, DM}; StaticOrder S; S.init(MROWS, FF, F.G, F.bid, DM);
        pg8::EpiSq E{U};
        pg8::gemm_phase<pg8::EpiSq, StaticOrder, true, true>(F.lds, g, S, E); } SEAM(15);
    if (IN(16)) REPS(16) { Gemm g{U, (const bf16*)(ws + WS_WM2T) + (size_t)FF * DM, MROWS, DM, FF}; pg8::SplitOrder S; S.init(F.G, F.bid, FF);
        pg8::EpiRes E{H, H, (float*)(ws + WS_PART)};
        pg8::gemm_phase<pg8::EpiRes, pg8::SplitOrder, true, true>(F.lds, g, S, E); } SEAM(16);
    if (IN(17)) REPS(17) { const int gw = F.bid * NWAVES + F.wave, NGW = F.G * NWAVES;
        norm_sample_rows<true>(F, H + (size_t)MP * DM, F.in[23], nullptr, F.out + OUT_YS);
        for (int m = gw; m < MP; m += NGW) rms_row_f32(H + (size_t)m * DM, F.in[23], F.out + (size_t)m * DM, F.lane); }
#undef IN
#undef SEAM
}

extern "C" void kernel_launch(void* const* d_in, const int* in_sizes, int n_in, void* d_out, int out_size, void* d_ws, size_t ws_size, hipStream_t stream) {
    static int grid = 0;
    if (grid == 0) {
        if (n_in != 24 || in_sizes[0] != MP * DM || (size_t)out_size != OUT_END || ws_size < WS_END) {
            fprintf(stderr, "kernel_launch: unexpected shapes: n_in %d in0 %d out %d (want %zu) ws %zu (want >= %zu)\n", n_in, n_in > 0 ? in_sizes[0] : -1, out_size, (size_t)OUT_END, ws_size, (size_t)WS_END); grid = -1; return; }
        int dev = 0, cus = 0, per_cu = 0;
        if (hipGetDevice(&dev) != hipSuccess || hipDeviceGetAttribute(&cus, hipDeviceAttributeMultiprocessorCount, dev) != hipSuccess) { fprintf(stderr, "kernel_launch: device query failed\n"); grid = -1; return; }
        if (hipFuncSetAttribute((const void*)mega_fwd, hipFuncAttributeMaxDynamicSharedMemorySize, LDS_BYTES) != hipSuccess) { fprintf(stderr, "kernel_launch: hipFuncSetAttribute failed\n"); grid = -1; return; }
        if (hipOccupancyMaxActiveBlocksPerMultiprocessor(&per_cu, (const void*)mega_fwd, NTHR, LDS_BYTES) != hipSuccess || per_cu < 1) { fprintf(stderr, "kernel_launch: occupancy query says %d blocks per CU\n", per_cu); }
        (void)hipGetLastError();
        grid = cus;
    }
    if (grid < 0) return;
    (void)hipMemsetAsync((char*)d_ws + WS_CTL, 0, CTL_ZERO_BYTES, stream);
    Args a{};
    for (int i = 0; i < 24; ++i) a.in[i] = (const float*)d_in[i];
    a.out = (float*)d_out; a.ws = (unsigned char*)d_ws;
#if MK_ONE_LAUNCH
    a.ph_lo = 0; a.ph_hi = NPH;
    hipLaunchKernelGGL(mega_fwd, dim3(grid), dim3(NTHR), LDS_BYTES, stream, a);
#else
    for (int p = 0; p < NPH; ++p) { a.ph_lo = p; a.ph_hi = p + 1; hipLaunchKernelGGL(mega_fwd, dim3(grid), dim3(NTHR), LDS_BYTES, stream, a); }
#endif
    const hipError_t le = hipPeekAtLastError();
    if (le != hipSuccess) fprintf(stderr, "kernel_launch: launch failed: %s\n", hipGetErrorName(le));
}
```

```cpp
#include <hip/hip_runtime.h>
#include <cstdio>
#include <cstdint>

#define GAS __attribute__((address_space(1)))
#define LAS __attribute__((address_space(3)))
typedef unsigned short bf16;
typedef unsigned v4u __attribute__((ext_vector_type(4)));
typedef unsigned v2u __attribute__((ext_vector_type(2)));
typedef float f32x2 __attribute__((ext_vector_type(2)));
typedef float f32x4 __attribute__((ext_vector_type(4)));
typedef float f32x16 __attribute__((ext_vector_type(16)));
typedef short bf16x8 __attribute__((ext_vector_type(8)));
typedef short s16x4 __attribute__((ext_vector_type(4)));
typedef __bf16 bf16x2_t __attribute__((ext_vector_type(2)));
typedef GAS unsigned gu32;
#define RLX_AGENT __ATOMIC_RELAXED, __HIP_MEMORY_SCOPE_AGENT
#define DI __device__ __forceinline__

DI unsigned pk2(float lo, float hi) { f32x2 v = {lo, hi}; bf16x2_t b = __builtin_convertvector(v, bf16x2_t); return __builtin_bit_cast(unsigned, b); }
DI float bflo(unsigned u) { return __uint_as_float(u << 16); }
DI float bfhi(unsigned u) { return __uint_as_float(u & 0xffff0000u); }
DI float wave_sum(float v) {
#pragma unroll
    for (int o = 1; o < 64; o <<= 1) v += __shfl_xor(v, o);
    return v;
}
DI int crow(int reg, int h) { return (reg & 3) + 8 * (reg >> 2) + 4 * h; }
#define MFMA32(a, b, c) __builtin_amdgcn_mfma_f32_32x32x16_bf16((a), (b), (c), 0, 0, 0)
DI s16x4 trr(const LAS unsigned char* p) { return __builtin_bit_cast(s16x4, __builtin_amdgcn_ds_read_tr16_b64_v4i16((LAS s16x4*)p)); }
DI bf16x8 cat8(s16x4 lo, s16x4 hi) { return __builtin_shufflevector(lo, hi, 0, 1, 2, 3, 4, 5, 6, 7); }
DI bf16x8 pack8(float a0, float a1, float a2, float a3, float a4, float a5, float a6, float a7) {
    v4u p; p.x = pk2(a0, a1); p.y = pk2(a2, a3); p.z = pk2(a4, a5); p.w = pk2(a6, a7); return __builtin_bit_cast(bf16x8, p);
}
DI float fexp2(float x) { return __builtin_amdgcn_exp2f(x); }
DI float fexp(float x) { return __builtin_amdgcn_exp2f(x * 1.4426950408889634f); }
DI float sigmoidf_(float x) { return 1.0f / (1.0f + fexp(-x)); }
DI float siluf_(float x) { return x * sigmoidf_(x); }
DI float softplusf_(float x) { return x > 20.f ? x : log1pf(__expf(x)); }

DI size_t ablk(int r, int c, int K) { return ((size_t)(r >> 8) * (K >> 6) + (c >> 6)) * 16384 + (size_t)((r & 255) * 64 + (c & 63)); }

namespace pg8 {
#define PG8_LAS __attribute__((address_space(3)))
typedef unsigned short bf16_t;
typedef short bf16x8 __attribute__((ext_vector_type(8)));
typedef float f32x4 __attribute__((ext_vector_type(4)));
typedef unsigned u32x4 __attribute__((ext_vector_type(4)));
constexpr int BM = 256, BK = 64, HALF = 128, HTB = HALF * BK * 2  , STAGE_BYTES = 8 * HTB, NXCD = 8, WGM = 8;

__host__ __device__ __forceinline__ int lds_byte(int r, int c) { const int st = (r >> 4) * 2 + (c >> 5), rr = r & 15, cc = c & 31, ob = rr * 64 + cc * 2; return st * 1024 + (ob ^ (((ob >> 9) & 1) << 5)); }
__host__ __device__ __forceinline__ void stage_rc(int b, int& R, int& C) { const int st = b / 1024, sb = b % 1024, swz = sb ^ (((sb >> 9) & 1) << 5); R = (st >> 1) * 16 + swz / 64; C = (st & 1) * 32 + (swz % 64) / 2; }
__host__ __device__ __forceinline__ int perm32(int rho) { const int n = rho >> 4, i = rho & 15; return 8 * (i >> 2) + 4 * n + (i & 3); }

struct Unit { int pm, pn, k0, nt; };
struct Gemm { const bf16_t* A; const bf16_t* Bt; int M, N, K; };

struct StaticOrder {
    int nM, nN, nwg, G, c, ntf;
    __host__ __device__ void init(int M, int N, int G_, int c_, int K_) { nM = M / BM; nN = N / BM; nwg = nM * nN; G = G_; c = c_; ntf = K_ / BK; }
    __host__ __device__ bool next(int i, Unit& u) const {
        const long L = (long)i * G + c; if (L >= nwg) return false;
        int wgid = (int)L; { const int q = nwg / NXCD, r = nwg % NXCD, xcd = wgid % NXCD, off = wgid / NXCD; wgid = (xcd < r ? xcd * (q + 1) : r * (q + 1) + (xcd - r) * q) + off; }
        const int nig = WGM * nN, gid = wgid / nig, fm = gid * WGM, gsz = (nM - fm) < WGM ? (nM - fm) : WGM;
        u.pm = fm + ((wgid % nig) % gsz); u.pn = (wgid % nig) / gsz; u.k0 = 0; u.nt = ntf; return true;
    }
    __device__ __forceinline__ void a_ready(const Unit&) const {}
    __device__ __forceinline__ void done(const Unit&) const {}
};

template <class Epi, class Sched, bool ALIGN_EPI = false, bool SP2 = false>
__device__ __forceinline__ void gemm_phase(PG8_LAS unsigned char* lds, const Gemm g, const Sched& S, const Epi& E) {
    const int tid = threadIdx.x, wid = __builtin_amdgcn_readfirstlane(tid >> 6), lane = tid & 63, wr = wid >> 2, wc = wid & 3, fr = lane & 15, fq = lane >> 4;
    const int K = g.K;
    unsigned voffA[2], voffB[2];
#pragma unroll
    for (int i = 0; i < 2; ++i) { int R, C; stage_rc(tid * 16 + i * 8192, R, C); const int Rb = Epi::PERM ? ((R & ~31) + perm32(R & 31)) : R;
        voffA[i] = (unsigned)(R * BK + C) * 2u; voffB[i] = (unsigned)(Rb * BK + C) * 2u; }
    const size_t kstep = (size_t)BM * BK * 2;
    const size_t hstep = (size_t)HALF * BK * 2;
    const size_t tstep = (size_t)(K / BK) * kstep;
    const size_t kstepB = (size_t)BM * BK * 2, hstepB = (size_t)HALF * BK * 2, tstepB = (size_t)(K / BK) * kstepB;
    const unsigned ldsw = (unsigned)wid * 1024u;
    const int aoff = lds_byte(wr * 64 + fr, fq * 8), boff = lds_byte(wc * 32 + fr, fq * 8);
#define PG8_SA(b, h) (((b) * 2 + (h)) * HTB)
#define PG8_SB(b, h) ((4 + (b) * 2 + (h)) * HTB)
#define PG8_STAGE(bufoff, gbase, voff) do { _Pragma("unroll") for (int _i = 0; _i < 2; ++_i) \
        __builtin_amdgcn_global_load_lds((const unsigned*)((const char*)(gbase) + (voff)[_i]), (PG8_LAS unsigned*)(lds + (bufoff) + ldsw + _i * 8192), 16, 0, 0); } while (0)
#define PG8_LDA(dst, b, h) do { _Pragma("unroll") for (int m = 0; m < 4; ++m) _Pragma("unroll") for (int k = 0; k < 2; ++k) dst[m][k] = *(const PG8_LAS bf16x8*)(lds + PG8_SA(b, h) + aoff + m * 2048 + k * 1024); } while (0)
#define PG8_LDB(dst, b, h) do { _Pragma("unroll") for (int n = 0; n < 2; ++n) _Pragma("unroll") for (int k = 0; k < 2; ++k) dst[n][k] = *(const PG8_LAS bf16x8*)(lds + PG8_SB(b, h) + boff + n * 2048 + k * 1024); } while (0)
#define PG8_MMA(ai, bj, At, Bt) do { __builtin_amdgcn_s_setprio(1); _Pragma("unroll") for (int m = 0; m < 4; ++m) _Pragma("unroll") for (int n = 0; n < 2; ++n) _Pragma("unroll") for (int k = 0; k < 2; ++k) \
        acc[ai][bj][m][n] = __builtin_amdgcn_mfma_f32_16x16x32_bf16(Bt[n][k], At[m][k], acc[ai][bj][m][n], 0, 0, 0); __builtin_amdgcn_s_setprio(0); } while (0)
#define PG8_WAIT_V(n) asm volatile("s_waitcnt vmcnt(" #n ")" ::: "memory")
#define PG8_WAIT_L(n) asm volatile("s_waitcnt lgkmcnt(" #n ")" ::: "memory")
#define PG8_BAR __builtin_amdgcn_s_barrier()
#define PG8_SCHED __builtin_amdgcn_sched_barrier(0)
    Unit cur, nxt; int ui = 0;
    if (!S.next(0, cur)) return;
    f32x4 acc[2][2][4][2];
#pragma unroll
    for (int a = 0; a < 2; ++a)
#pragma unroll
        for (int b = 0; b < 2; ++b)
#pragma unroll
            for (int m = 0; m < 4; ++m)
#pragma unroll
                for (int n = 0; n < 2; ++n) acc[a][b][m][n] = (f32x4){0.f, 0.f, 0.f, 0.f};
    bf16x8 At[4][2], B0[2][2], B1[2][2];
    const char* cA = (const char*)g.A + (size_t)cur.pm * tstep + (size_t)(cur.k0 / BK) * kstep; const char* cB = (const char*)g.Bt + (size_t)cur.pn * tstepB + (size_t)(cur.k0 / BK) * kstepB;
#define PG8_ROT(u) 0
    int rot = PG8_ROT(cur);
    S.a_ready(cur);
    { const size_t o0 = (size_t)rot; cA += o0 * kstep; cB += o0 * kstepB; }
    if constexpr (SP2) {
        PG8_STAGE(PG8_SB(0, 0), cB, voffB); PG8_STAGE(PG8_SB(0, 1), cB + hstepB, voffB); PG8_STAGE(PG8_SA(0, 0), cA, voffA); PG8_STAGE(PG8_SA(0, 1), cA + hstep, voffA);
        if (wr == 1) PG8_BAR;
        PG8_WAIT_V(2); PG8_BAR;
        PG8_STAGE(PG8_SB(1, 0), cB + kstepB, voffB); PG8_STAGE(PG8_SA(1, 0), cA + kstep, voffA); PG8_STAGE(PG8_SB(1, 1), cB + hstepB + kstepB, voffB);
        PG8_WAIT_V(6); PG8_BAR;
    } else {
        PG8_STAGE(PG8_SB(0, 0), cB, voffB); PG8_STAGE(PG8_SA(0, 0), cA, voffA); PG8_STAGE(PG8_SB(0, 1), cB + hstepB, voffB); PG8_STAGE(PG8_SA(0, 1), cA + hstep, voffA);
        if (wr == 1) PG8_BAR;
        PG8_WAIT_V(4); PG8_BAR;
        PG8_STAGE(PG8_SB(1, 0), cB + kstepB, voffB); PG8_STAGE(PG8_SA(1, 0), cA + kstep, voffA); PG8_STAGE(PG8_SB(1, 1), cB + hstepB + kstepB, voffB);
        PG8_WAIT_V(6); PG8_BAR;
    }
    cA -= (size_t)rot * kstep; cB -= (size_t)rot * kstepB;
    for (;;) {
        const bool has_next = S.next(ui + 1, nxt);
        const char* nA = has_next ? (const char*)g.A + (size_t)nxt.pm * tstep + (size_t)(nxt.k0 / BK) * kstep : cA; const char* nB = has_next ? (const char*)g.Bt + (size_t)nxt.pn * tstepB + (size_t)(nxt.k0 / BK) * kstepB : cB;
        const int nt = cur.nt, ntm = nt - 1; const int nrot = has_next ? PG8_ROT(nxt) : rot;
        for (int t = 0; t < nt; t += 2) {
            const bool last = (t == nt - 2);
            const char* a1 = cA + (size_t)((t + rot) & ntm) * kstep + kstep;
            const char* a2 = last ? nA + (size_t)nrot * kstep : cA + (size_t)((t + 2 + rot) & ntm) * kstep; const char* b2 = last ? nB + (size_t)nrot * kstepB : cB + (size_t)((t + 2 + rot) & ntm) * kstepB;
            const char* a3 = a2 + kstep; const char* b3 = b2 + kstepB;
            if (last && has_next) S.a_ready(nxt);
            if constexpr (SP2) {
            PG8_LDB(B0, 0, 0); PG8_LDB(B1, 0, 1); PG8_SCHED; PG8_LDA(At, 0, 0); PG8_STAGE(PG8_SA(1, 1), a1 + hstep, voffA);
            PG8_WAIT_V(8); PG8_WAIT_L(0); PG8_BAR; PG8_MMA(0, 0, At, B0); PG8_MMA(0, 1, At, B1); PG8_BAR; PG8_SCHED;
            PG8_LDA(At, 0, 1); PG8_STAGE(PG8_SB(0, 0), b2, voffB); PG8_STAGE(PG8_SB(0, 1), b2 + hstepB, voffB); PG8_STAGE(PG8_SA(0, 0), a2, voffA);
            PG8_WAIT_V(8); PG8_WAIT_L(0); PG8_BAR; PG8_MMA(1, 0, At, B0); PG8_MMA(1, 1, At, B1); PG8_BAR; PG8_SCHED;
            PG8_LDB(B0, 1, 0); PG8_LDB(B1, 1, 1); PG8_SCHED; PG8_LDA(At, 1, 0); PG8_STAGE(PG8_SA(0, 1), a2 + hstep, voffA);
            PG8_WAIT_V(8); PG8_WAIT_L(0); PG8_BAR; PG8_MMA(0, 0, At, B0); PG8_MMA(0, 1, At, B1); PG8_BAR; PG8_SCHED;
            PG8_LDA(At, 1, 1); PG8_STAGE(PG8_SB(1, 0), b3, voffB); PG8_STAGE(PG8_SB(1, 1), b3 + hstepB, voffB); PG8_STAGE(PG8_SA(1, 0), a3, voffA);
            PG8_WAIT_V(8); PG8_WAIT_L(0); PG8_BAR; PG8_MMA(1, 0, At, B0); PG8_MMA(1, 1, At, B1); PG8_BAR; PG8_SCHED;
            } else {
            PG8_LDB(B0, 0, 0); PG8_SCHED; PG8_LDA(At, 0, 0); PG8_STAGE(PG8_SA(1, 1), a1 + hstep, voffA);
            PG8_WAIT_L(8); PG8_BAR; PG8_WAIT_L(0); PG8_MMA(0, 0, At, B0); PG8_BAR; PG8_SCHED;
            PG8_LDB(B1, 0, 1); PG8_STAGE(PG8_SB(0, 0), b2, voffB);
            PG8_BAR; PG8_WAIT_L(0); PG8_MMA(0, 1, At, B1); PG8_BAR;
            PG8_LDA(At, 0, 1); PG8_STAGE(PG8_SA(0, 0), a2, voffA);
            PG8_BAR; PG8_WAIT_L(0); PG8_MMA(1, 0, At, B0); PG8_BAR; PG8_SCHED;
            PG8_STAGE(PG8_SB(0, 1), b2 + hstepB, voffB);
            PG8_WAIT_V(6); PG8_BAR; PG8_MMA(1, 1, At, B1); PG8_BAR;
            PG8_LDB(B0, 1, 0); PG8_SCHED; PG8_LDA(At, 1, 0); PG8_STAGE(PG8_SA(0, 1), a2 + hstep, voffA);
            PG8_WAIT_L(8); PG8_BAR; PG8_WAIT_L(0); PG8_MMA(0, 0, At, B0); PG8_BAR; PG8_SCHED;
            PG8_LDB(B1, 1, 1); PG8_STAGE(PG8_SB(1, 0), b3, voffB);
            PG8_BAR; PG8_WAIT_L(0); PG8_MMA(0, 1, At, B1); PG8_BAR;
            PG8_LDA(At, 1, 1); PG8_STAGE(PG8_SA(1, 0), a3, voffA);
            PG8_BAR; PG8_WAIT_L(0); PG8_MMA(1, 0, At, B0); PG8_BAR; PG8_SCHED;
            PG8_STAGE(PG8_SB(1, 1), b3 + hstepB, voffB);
            PG8_WAIT_V(6); PG8_BAR; PG8_MMA(1, 1, At, B1); PG8_BAR;
            }
        }
        if constexpr (ALIGN_EPI) { if (wr == 0) PG8_BAR; }
        if constexpr (!Epi::AFTER_DRAIN) { E(acc, cur, wr, wc, fr, fq); S.done(cur); }
        if (!has_next) break;
#pragma unroll
        for (int a = 0; a < 2; ++a)
#pragma unroll
            for (int b = 0; b < 2; ++b)
#pragma unroll
                for (int m = 0; m < 4; ++m)
#pragma unroll
                    for (int n = 0; n < 2; ++n) acc[a][b][m][n] = (f32x4){0.f, 0.f, 0.f, 0.f};
        cur = nxt; cA = nA; cB = nB; rot = nrot; ++ui;
        if constexpr (ALIGN_EPI) { if (wr == 1) PG8_BAR; }
    }
    PG8_WAIT_V(0);
    if constexpr (!ALIGN_EPI) { if (wr == 0) PG8_BAR; }
    PG8_BAR;
    if constexpr (Epi::AFTER_DRAIN) { E.fused(acc, cur, wr, wc, fr, fq, lds, wid, lane); S.done(cur); }
#undef PG8_SA
#undef PG8_SB
#undef PG8_STAGE
#undef PG8_LDA
#undef PG8_LDB
#undef PG8_MMA
#undef PG8_WAIT_V
#undef PG8_WAIT_L
#undef PG8_BAR
#undef PG8_SCHED
#undef PG8_ROT
}
}

constexpr int NWAVES = 8, NTHR = 512;
constexpr int DM = 2048, MP = 8192, MS = 512, MROWS = MP + MS;
constexpr int N1 = 8448, N5 = 7168, FF = 8192, KMIX = 4096;
constexpr int C_Z = 0, C_XBC = 2048, C_Q = 5120, C_K = 7168, C_V = 7680, C_DT = 8192;
constexpr int O_Q = 0, O_K = 6144, O_V = 6656;
constexpr int CONVD = 3072;
constexpr float EPS = 1e-5f;
constexpr int NPH = 18;
#ifndef MK_ONE_LAUNCH
#define MK_ONE_LAUNCH 1
#endif

constexpr size_t OUT_YP = 0, OUT_YS = OUT_YP + (size_t)MP * DM, OUT_PCONV = OUT_YS + (size_t)MS * DM, OUT_PSSM = OUT_PCONV + 3 * CONVD,
    OUT_PSWAK = OUT_PSSM + 32 * 64 * 128, OUT_PSWAV = OUT_PSWAK + 128 * 512, OUT_PDILK = OUT_PSWAV + 128 * 512, OUT_PDILV = OUT_PDILK + 2048 * 512,
    OUT_SCONV = OUT_PDILV + 2048 * 512, OUT_SSSM = OUT_SCONV + 128 * 3 * CONVD, OUT_SSWAK = OUT_SSSM + (size_t)128 * 32 * 64 * 128,
    OUT_SSWAV = OUT_SSWAK + 512 * 512, OUT_SDILK = OUT_SSWAV + 512 * 512, OUT_SDILV = OUT_SDILK + 512 * 512, OUT_END = OUT_SDILV + 512 * 512;

constexpr size_t MiB = 1u << 20;
constexpr size_t WS_CTL = 0, CTL_ZERO_BYTES = 1 * MiB;
constexpr size_t WS_ROPE = 1 * MiB, WS_DT = 2 * MiB, WS_CD = 4 * MiB, WS_LSE = 5 * MiB;
constexpr size_t WS_W1T = 16 * MiB, WS_W2T = 50 * MiB, WS_WM1T = 66 * MiB, WS_WM2T = 130 * MiB, WS_W5T = 194 * MiB, WS_W6T = 222 * MiB;
constexpr size_t WS_XN = 230 * MiB, WS_P1 = 264 * MiB, WS_XC = 405 * MiB, WS_ST = 453 * MiB, WS_HIN = 517 * MiB, WS_MIX = 549 * MiB, WS_H = 617 * MiB;
constexpr size_t WS_U = 685 * MiB, WS_P5 = 821 * MiB, WS_O3 = 940 * MiB, WS_MRG = 1042 * MiB, WS_PART = 1076 * MiB, WS_END = 1140 * MiB;
static_assert(WS_W1T + (size_t)N1 * DM * 2 <= WS_W2T && WS_P1 + (size_t)MROWS * N1 * 2 <= WS_XC && WS_U + (size_t)MROWS * FF * 2 <= WS_P5 && WS_P5 + (size_t)MROWS * N5 * 2 <= WS_O3 && WS_O3 + (size_t)3 * MROWS * DM * 2 <= WS_MRG, "ws map");
constexpr int CW_TMO = 0, CW_BAR = 4096;

constexpr int LDS_BYTES = 163840 - 1024;
constexpr int MISC_OFF = LDS_BYTES - 256;

#define XB_TMO      128
#define XB_XCNT(j)  (256  + 64 * (j))
#define XB_XSUB(j)  (1280 + 64 * (j))
#define XB_XGEN(j)  (2304 + 64 * (j))
#define XB_TOP      3328
#define XB_TOPGEN   3392
#define XCD_BAR_WORDS 3456
#define XB_SPIN_CAP (1u << 18)

__device__ __forceinline__ unsigned xb_ld(unsigned* p)              { return __hip_atomic_load(p, __ATOMIC_RELAXED, __HIP_MEMORY_SCOPE_AGENT); }
__device__ __forceinline__ unsigned xb_add(unsigned* p, unsigned v) { return __hip_atomic_fetch_add(p, v, __ATOMIC_RELAXED, __HIP_MEMORY_SCOPE_AGENT); }
__device__ __forceinline__ unsigned xb_xcc_id() { return (unsigned)__builtin_amdgcn_s_getreg((3 << 11) | 20) & 0xFu; }
#define XB_SPIN(cond, bar) do { unsigned _sp = 0; while (cond) { __builtin_amdgcn_s_sleep(1); \
    if ((++_sp & 255u) == 0u) { if (xb_ld(&(bar)[XB_TMO])) break; if (_sp > XB_SPIN_CAP) { atomicAdd(&(bar)[XB_TMO], 1u); break; } } } } while (0)

struct XcdBarrier {
    unsigned* bar; unsigned x;
    volatile LAS unsigned* st;
};

__device__ __forceinline__ XcdBarrier xcd_barrier_post(unsigned* bar, volatile LAS unsigned* st) {
    XcdBarrier b; b.bar = bar; b.x = xb_xcc_id(); b.st = st;
    if (threadIdx.x == 0) (void)xb_add(&bar[XB_XCNT(b.x)], 1u);
    return b;
}
__device__ __forceinline__ void xcd_barrier_complete(unsigned* bar, unsigned x, unsigned& nloc, unsigned& nx) {
    const unsigned G = gridDim.x * gridDim.y * gridDim.z;
    unsigned sum, cnt, mine, sp = 0u;
    for (;;) {
        sum = 0u; cnt = 0u; mine = 0u;
#pragma unroll
        for (unsigned j = 0; j < 16; ++j) { const unsigned c = xb_ld(&bar[XB_XCNT(j)]); sum += c; cnt += (c > 0u) ? 1u : 0u; mine = (j == x) ? c : mine; }
        if (sum == G) break;
        __builtin_amdgcn_s_sleep(1);
        if ((++sp & 255u) == 0u) { if (xb_ld(&bar[XB_TMO])) break; if (sp > XB_SPIN_CAP) { atomicAdd(&bar[XB_TMO], 1u); break; } }
    }
    nloc = mine > 0u ? mine : 1u; nx = cnt > 0u ? cnt : 1u;
}

__device__ __forceinline__ void xcd_barrier(const XcdBarrier& b) {
    asm volatile("s_waitcnt vmcnt(0)" ::: "memory");
    __syncthreads();
    if (threadIdx.x == 0) {
        unsigned* bar = b.bar;
        __builtin_amdgcn_s_waitcnt(0);
        unsigned nloc = b.st[0], nx = b.st[1];
        if (nloc == 0u) { xcd_barrier_complete(bar, b.x, nloc, nx); b.st[0] = nloc; b.st[1] = nx; }
        const unsigned old = xb_add(&bar[XB_XSUB(b.x)], 1u);
        const unsigned gen = old / nloc;
        if (old + 1u == (gen + 1u) * nloc) {
            __builtin_amdgcn_fence(__ATOMIC_RELEASE, "agent");
            asm volatile("s_waitcnt vmcnt(0)" ::: "memory");
            const unsigned og = xb_add(&bar[XB_TOP], 1u);
            const unsigned tg = og / nx;
            if (og + 1u == (tg + 1u) * nx) xb_add(&bar[XB_TOPGEN], 1u);
            else XB_SPIN(xb_ld(&bar[XB_TOPGEN]) == tg, bar);
            __builtin_amdgcn_fence(__ATOMIC_ACQUIRE, "agent");
            xb_add(&bar[XB_XGEN(b.x)], 1u);
            asm volatile("s_waitcnt vmcnt(0)" ::: "memory");
        } else {
            XB_SPIN(xb_ld(&bar[XB_XGEN(b.x)]) == gen, bar);
            __builtin_amdgcn_fence(__ATOMIC_ACQUIRE, "agent");
            asm volatile("s_waitcnt vmcnt(0)" ::: "memory");
        }
    }
    __syncthreads();
}

namespace pg8 {
DI void st_bf16x8(bf16* p, f32x4 v0, f32x4 v1) { v4u w; w.x = pk2(v0[0], v0[1]); w.y = pk2(v0[2], v0[3]); w.z = pk2(v1[0], v1[1]); w.w = pk2(v1[2], v1[3]); *(v4u*)p = w; }
DI void st_f32x8(float* p, f32x4 v0, f32x4 v1) { *(f32x4*)p = v0; *(f32x4*)(p + 4) = v1; }
DI int row_pos(int r) { return r < MP ? r : MP + (r & 3); }
DI void rope8(f32x4& v0, f32x4& v1, const float* rope, int pos, int fq) {
    f32x4 o0, o1;
#pragma unroll
    for (int e = 0; e < 4; ++e) { o0[e] = __shfl_xor(v0[e], 16); o1[e] = __shfl_xor(v1[e], 16); }
    if (fq < 2) {
        const f32x4 c0 = *(const f32x4*)(rope + pos * 16), c1 = *(const f32x4*)(rope + pos * 16 + 4), s0 = *(const f32x4*)(rope + pos * 16 + 8), s1 = *(const f32x4*)(rope + pos * 16 + 12);
        const float sg = fq == 0 ? -1.f : 1.f;
        v0 = v0 * c0 + (o0 * s0) * sg; v1 = v1 * c1 + (o1 * s1) * sg;
    }
}
struct EpiProj1 {
    static constexpr bool PERM = true, AFTER_DRAIN = false;
    bf16* P1; float* DT; const float* rope; float* out;
    DI void operator()(const f32x4 (&acc)[2][2][4][2], const Unit& u, int wr, int wc, int fr, int fq) const {
        const int pn = u.pn, row0 = u.pm * BM + wr * 64 + fr;
        if (pn == 32) {
            if (wc == 0) {
#pragma unroll
                for (int ai = 0; ai < 2; ++ai)
#pragma unroll
                    for (int m = 0; m < 4; ++m) { const int r = row0 + ai * HALF + m * 16; st_f32x8(DT + (size_t)r * 32 + 8 * fq, acc[ai][0][m][0], acc[ai][0][m][1]); }
            }
            return;
        }
        const bool dorope = (pn >= 20 && pn < 30) && ((wc & 1) == 0);
#pragma unroll
        for (int ai = 0; ai < 2; ++ai)
#pragma unroll
            for (int m = 0; m < 4; ++m) {
                const int r = row0 + ai * HALF + m * 16, pos = row_pos(r);
#pragma unroll
                for (int bj = 0; bj < 2; ++bj) {
                    const int cb = pn * BM + bj * HALF + wc * 32 + 8 * fq;
                    f32x4 v0 = acc[ai][bj][m][0], v1 = acc[ai][bj][m][1];
                    if (dorope) rope8(v0, v1, rope, pos, fq);
                    st_bf16x8(P1 + (size_t)r * N1 + cb, v0, v1);
                    if (u.pm >= 31) {
                        if (pn >= 8 && pn < 20) {
                            const int c = cb - C_XBC;
                            if (r >= MP - 3 && r < MP) st_f32x8(out + OUT_PCONV + (size_t)(r - (MP - 3)) * CONVD + c, v0, v1);
                            if (r >= MP) { const int t = (r - MP) & 3, b = (r - MP) >> 2; if (t >= 1) st_f32x8(out + OUT_SCONV + ((size_t)b * 3 + (t - 1)) * CONVD + c, v0, v1); }
                        } else if (pn >= 28 && pn < 30) {
                            const int c = cb - C_K;
                            if (r >= MP - 128 && r < MP) st_f32x8(out + OUT_PSWAK + (size_t)(r - (MP - 128)) * 512 + c, v0, v1);
                            if (r >= MP) st_f32x8(out + OUT_SSWAK + (size_t)(r - MP) * 512 + c, v0, v1);
                        } else if (pn >= 30) {
                            const int c = cb - C_V;
                            if (r >= MP - 128 && r < MP) st_f32x8(out + OUT_PSWAV + (size_t)(r - (MP - 128)) * 512 + c, v0, v1);
                            if (r >= MP) st_f32x8(out + OUT_SSWAV + (size_t)(r - MP) * 512 + c, v0, v1);
                        }
                    }
                }
            }
    }
};
struct EpiProj5 {
    static constexpr bool PERM = true, AFTER_DRAIN = false;
    bf16* P5; const float* rope; float* out; int skip;
    DI void operator()(const f32x4 (&acc)[2][2][4][2], const Unit& u, int wr, int wc, int fr, int fq) const {
#ifdef PROBE_EPISKIP
        if (skip) return;
#endif
        const int pn = u.pn, row0 = u.pm * BM + wr * 64 + fr;
        const bool dorope = (pn < 26) && ((wc & 1) == 0);
#pragma unroll
        for (int ai = 0; ai < 2; ++ai)
#pragma unroll
            for (int m = 0; m < 4; ++m) {
                const int r = row0 + ai * HALF + m * 16, pos = row_pos(r);
#pragma unroll
                for (int bj = 0; bj < 2; ++bj) {
                    const int cb = pn * BM + bj * HALF + wc * 32 + 8 * fq;
                    f32x4 v0 = acc[ai][bj][m][0], v1 = acc[ai][bj][m][1];
                    if (dorope) rope8(v0, v1, rope, pos, fq);
                    st_bf16x8(P5 + (size_t)r * N5 + cb, v0, v1);
                    if (u.pm >= 24 && pn >= 24) {
                        const bool isk = pn < 26; const int c = cb - (isk ? O_K : O_V);
                        if (r >= MP - 2048 && r < MP) st_f32x8(out + (isk ? OUT_PDILK : OUT_PDILV) + (size_t)(r - (MP - 2048)) * 512 + c, v0, v1);
                        if (r >= MP) st_f32x8(out + (isk ? OUT_SDILK : OUT_SDILV) + (size_t)(r - MP) * 512 + c, v0, v1);
                    }
                }
            }
    }
};
struct SplitOrder {
    StaticOrder P; int K;
    DI void init(int G_, int c_, int K_) { P.init(MP, DM, G_, c_, K_); K = K_; }
    DI bool next(int i, Unit& u) const {
        const int L = i * P.G + P.c; if (L >= 512) return false;
        if (L < 256) { const int q = L / P.G; StaticOrder T = P; T.c = L - q * P.G; return T.next(q, u); }
        const int s = L - 256, unit = s >> 4, sl = s & 15; u.pm = 32 + (unit >> 3); u.pn = unit & 7; u.k0 = sl * (K / 16); u.nt = K / 16 / BK; return true;
    }
    DI void a_ready(const Unit&) const {}
    DI void done(const Unit&) const {}
};
struct EpiRes {
    static constexpr bool PERM = true, AFTER_DRAIN = false;
    const float* resP; float* H; float* PART;
    DI void operator()(const f32x4 (&acc)[2][2][4][2], const Unit& u, int wr, int wc, int fr, int fq) const {
        const int row0 = u.pm * BM + wr * 64 + fr;
        if (u.pm >= 32) {
            float* pb = PART + (size_t)(u.k0 / (u.nt * BK)) * MS * DM;
#pragma unroll
            for (int ai = 0; ai < 2; ++ai)
#pragma unroll
                for (int m = 0; m < 4; ++m) {
                    const int r = row0 + ai * HALF + m * 16 - MP;
#pragma unroll
                    for (int bj = 0; bj < 2; ++bj) st_f32x8(pb + (size_t)r * DM + u.pn * BM + bj * HALF + wc * 32 + 8 * fq, acc[ai][bj][m][0], acc[ai][bj][m][1]);
                }
            return;
        }
#pragma unroll
        for (int ai = 0; ai < 2; ++ai)
#pragma unroll
            for (int m = 0; m < 4; ++m) {
                const int r = row0 + ai * HALF + m * 16;
                const float* rp = resP + (size_t)r * DM;
#pragma unroll
                for (int bj = 0; bj < 2; ++bj) {
                    const int cb = u.pn * BM + bj * HALF + wc * 32 + 8 * fq;
                    const f32x4 a0 = *(const f32x4*)(rp + cb), a1 = *(const f32x4*)(rp + cb + 4);
                    st_f32x8(H + (size_t)r * DM + cb, acc[ai][bj][m][0] + a0, acc[ai][bj][m][1] + a1);
                }
            }
    }
};
struct EpiSq {
    static constexpr bool PERM = true, AFTER_DRAIN = false;
    bf16* U;
    DI void operator()(const f32x4 (&acc)[2][2][4][2], const Unit& u, int wr, int wc, int fr, int fq) const {
        const int row0 = u.pm * BM + wr * 64 + fr;
#pragma unroll
        for (int ai = 0; ai < 2; ++ai)
#pragma unroll
            for (int m = 0; m < 4; ++m) {
                const int r = row0 + ai * HALF + m * 16;
#pragma unroll
                for (int bj = 0; bj < 2; ++bj) {
                    const int cb = u.pn * BM + bj * HALF + wc * 32 + 8 * fq;
                    f32x4 v0 = acc[ai][bj][m][0], v1 = acc[ai][bj][m][1];
#pragma unroll
                    for (int e = 0; e < 4; ++e) { const float a = fmaxf(v0[e], 0.f), b = fmaxf(v1[e], 0.f); v0[e] = a * a; v1[e] = b * b; }
                    st_bf16x8(U + ablk(r, cb, FF), v0, v1);
                }
            }
    }
};
}

struct Frame {
    LAS unsigned char* lds;
    int tid, lane, wave, G, bid;
    const float* const* in; float* out; unsigned char* ws;
};
#define LDS_WAIT() asm volatile("s_waitcnt lgkmcnt(0)" ::: "memory")

DI void transpose_item(const float* W, int N, bf16* WT, int K, int k0, int n0, int drow0, LAS float* scr, int lane) {
#pragma unroll 8
    for (int i = 0; i < 32; ++i) { const int kk = 2 * i + (lane >> 5); scr[kk * 33 + (lane & 31)] = W[(size_t)(k0 + kk) * N + n0 + (lane & 31)]; }
    LDS_WAIT(); asm volatile("" ::: "memory");
    const int c = lane & 7;
#pragma unroll
    for (int j = 0; j < 4; ++j) { const int n = (lane >> 3) + 8 * j; const LAS float* s = scr + (8 * c) * 33 + n;
        v4u o; o.x = pk2(s[0 * 33], s[1 * 33]); o.y = pk2(s[2 * 33], s[3 * 33]); o.z = pk2(s[4 * 33], s[5 * 33]); o.w = pk2(s[6 * 33], s[7 * 33]);
        const int nr = drow0 + n; *(GAS v4u*)(WT + ((size_t)(nr >> 8) * (K >> 6) + (k0 >> 6)) * 16384 + (nr & 255) * 64 + 8 * c) = o; }
    LDS_WAIT(); asm volatile("" ::: "memory");
}
DI int remap_w1(int n) { return n < 5120 ? n : (n < 5152 ? n - 5120 + C_DT : n - 32); }
DI void rms_row_bf16(const float* xrow, const float* g, bf16* XN, int m, int lane) {
    const GAS f32x4* xr = (const GAS f32x4*)xrow + lane;
    f32x4 v[8]; float s = 0.f;
#pragma unroll
    for (int j = 0; j < 8; ++j) { v[j] = xr[64 * j]; s += (v[j].x * v[j].x + v[j].y * v[j].y) + (v[j].z * v[j].z + v[j].w * v[j].w); }
    const float rs = 1.0f / sqrtf(wave_sum(s) * (1.f / DM) + EPS);
    const GAS f32x4* gr = (const GAS f32x4*)g + lane;
#pragma unroll
    for (int j = 0; j < 8; ++j) { const f32x4 gg = gr[64 * j]; v2u o; o.x = pk2(v[j].x * rs * gg.x, v[j].y * rs * gg.y); o.y = pk2(v[j].z * rs * gg.z, v[j].w * rs * gg.w); *(GAS v2u*)(XN + ablk(m, 4 * lane + 256 * j, DM)) = o; }
}
DI void rms_row_f32(const float* xrow, const float* g, float* orow, int lane) {
    const GAS f32x4* xr = (const GAS f32x4*)xrow + lane;
    f32x4 v[8]; float s = 0.f;
#pragma unroll
    for (int j = 0; j < 8; ++j) { v[j] = xr[64 * j]; s += (v[j].x * v[j].x + v[j].y * v[j].y) + (v[j].z * v[j].z + v[j].w * v[j].w); }
    const float rs = 1.0f / sqrtf(wave_sum(s) * (1.f / DM) + EPS);
    const GAS f32x4* gr = (const GAS f32x4*)g + lane;
    GAS f32x4* o = (GAS f32x4*)orow + lane;
#pragma unroll
    for (int j = 0; j < 8; ++j) { const f32x4 gg = gr[64 * j]; o[64 * j] = v[j] * rs * gg; }
}
template <bool F32OUT>
DI void norm_sample_rows(Frame& F, float* HS, const float* g, bf16* XNS, float* OUTS) {
    LAS float* red = (LAS float*)F.lds;
    const float* PART = (const float*)(F.ws + WS_PART);
    for (int rp = F.bid; rp < MS / 2; rp += F.G) {
        const int row = 2 * rp + (F.wave >> 2), col = (F.wave & 3) * 512 + 4 * F.lane;
        float* hrow = HS + (size_t)row * DM; const float* prow = PART + (size_t)row * DM;
        f32x4 v0 = *(const GAS f32x4*)(hrow + col), v1 = *(const GAS f32x4*)(hrow + col + 256);
#pragma unroll
        for (int s = 0; s < 16; ++s) { v0 += *(const GAS f32x4*)(prow + (size_t)s * MS * DM + col); v1 += *(const GAS f32x4*)(prow + (size_t)s * MS * DM + col + 256); }
        *(GAS f32x4*)(hrow + col) = v0; *(GAS f32x4*)(hrow + col + 256) = v1;
        float ss = (v0.x * v0.x + v0.y * v0.y) + (v0.z * v0.z + v0.w * v0.w) + (v1.x * v1.x + v1.y * v1.y) + (v1.z * v1.z + v1.w * v1.w);
        ss = wave_sum(ss);
        __syncthreads();
        if (F.lane == 0) red[F.wave] = ss;
        __syncthreads();
        const int w0 = F.wave & 4; const float tot = (red[w0] + red[w0 + 1]) + (red[w0 + 2] + red[w0 + 3]);
        const float rs = 1.0f / sqrtf(tot * (1.f / DM) + EPS);
        const f32x4 g0 = *(const f32x4*)(g + col), g1 = *(const f32x4*)(g + col + 256);
        if (F32OUT) { *(GAS f32x4*)(OUTS + (size_t)row * DM + col) = v0 * rs * g0; *(GAS f32x4*)(OUTS + (size_t)row * DM + col + 256) = v1 * rs * g1; }
        else { v2u a, b; a.x = pk2(v0.x * rs * g0.x, v0.y * rs * g0.y); a.y = pk2(v0.z * rs * g0.z, v0.w * rs * g0.w); b.x = pk2(v1.x * rs * g1.x, v1.y * rs * g1.y); b.y = pk2(v1.z * rs * g1.z, v1.w * rs * g1.w);
            *(GAS v2u*)(XNS + ablk(MP + row, col, DM)) = a; *(GAS v2u*)(XNS + ablk(MP + row, col + 256, DM)) = b; }
    }
}
DI void rms_load_row(const float* xrow, f32x4 (&v)[8], int lane) {
    const GAS f32x4* xr = (const GAS f32x4*)xrow + lane;
#pragma unroll
    for (int j = 0; j < 8; ++j) v[j] = xr[64 * j];
}
DI float rms_scale(const f32x4 (&v)[8]) {
    float s = 0.f;
#pragma unroll
    for (int j = 0; j < 8; ++j) s += (v[j].x * v[j].x + v[j].y * v[j].y) + (v[j].z * v[j].z + v[j].w * v[j].w);
    return 1.0f / sqrtf(wave_sum(s) * (1.f / DM) + EPS);
}
DI void norm_phase(Frame& F, const float* HP, float* HS, const float* g, bf16* XN, bool partials) {
    const int gw = F.bid * NWAVES + F.wave, NGW = F.G * NWAVES, lane = F.lane;
    if (partials) norm_sample_rows<false>(F, HS, g, XN, nullptr);
    const int mend = partials ? MP : MROWS;
    f32x4 gg[8];
    { const GAS f32x4* gr = (const GAS f32x4*)g + lane;
#pragma unroll
      for (int j = 0; j < 8; ++j) gg[j] = gr[64 * j]; }
    f32x4 cur[8], nxt[8];
    int m = gw;
    if (m < mend) rms_load_row(m < MP ? HP + (size_t)m * DM : HS + (size_t)(m - MP) * DM, cur, lane);
    for (; m < mend; m += NGW) {
        const int mn = m + NGW;
        if (mn < mend) rms_load_row(mn < MP ? HP + (size_t)mn * DM : HS + (size_t)(mn - MP) * DM, nxt, lane);
        const float rs = rms_scale(cur);
#pragma unroll
        for (int j = 0; j < 8; ++j) { v2u o; o.x = pk2(cur[j].x * rs * gg[j].x, cur[j].y * rs * gg[j].y); o.y = pk2(cur[j].z * rs * gg[j].z, cur[j].w * rs * gg[j].w); *(GAS v2u*)(XN + ablk(m, 4 * lane + 256 * j, DM)) = o; }
#pragma unroll
        for (int j = 0; j < 8; ++j) cur[j] = nxt[j];
    }
}

DI void convert_matrix(Frame& F, const float* W, int K, int N, bf16* WT, bool remap, int wrank, int nw) {
    LAS float* scr = (LAS float*)(F.lds + F.wave * 16384);
    const int nnb = N / 32, items = (K / 64) * nnb;
    for (int it = wrank; it < items; it += nw) { const int kb = it / nnb, nb = it - kb * nnb; transpose_item(W, N, WT, K, 64 * kb, 32 * nb, remap ? remap_w1(32 * nb) : 32 * nb, scr, F.lane); }
}
DI void convert_segment(Frame& F, int seg, int wrank, int nw) {
    unsigned char* ws = F.ws;
    if (seg == 0) convert_matrix(F, F.in[10], 2048, 8224, (bf16*)(ws + WS_W1T), true, wrank, nw);
    if (seg == 1) { convert_matrix(F, F.in[18], 4096, 2048, (bf16*)(ws + WS_W2T), false, wrank, nw);
                    convert_matrix(F, F.in[21], 2048, 8192, (bf16*)(ws + WS_WM1T), false, wrank, nw); }
    if (seg == 2) { convert_matrix(F, F.in[22], 8192, 2048, (bf16*)(ws + WS_WM2T), false, wrank, nw);
                    convert_matrix(F, F.in[19], 2048, 7168, (bf16*)(ws + WS_W5T), false, wrank, nw); }
    if (seg == 3) { convert_matrix(F, F.in[20], 2048, 2048, (bf16*)(ws + WS_W6T), false, wrank, nw);
                    convert_matrix(F, F.in[21] + (size_t)2048 * 8192, 2048, 8192, (bf16*)(ws + WS_WM1T) + (size_t)8192 * 2048, false, wrank, nw); }
    if (seg == 4) convert_matrix(F, F.in[22] + (size_t)8192 * 2048, 8192, 2048, (bf16*)(ws + WS_WM2T) + (size_t)2048 * 8192, false, wrank, nw);
}
DI void tail_convert(Frame& F, int nwg, int seg) {
    const int rem = nwg % F.G, first = rem == 0 ? 0 : rem;
    if (F.bid >= first) { convert_segment(F, seg, (F.bid - first) * NWAVES + F.wave, (F.G - first) * NWAVES); __syncthreads(); }
}

DI void p0_prologue(Frame& F) {
    unsigned char* ws = F.ws;
    convert_segment(F, 0, F.bid * NWAVES + F.wave, F.G * NWAVES);
    { unsigned char* tb = ws + WS_W1T + (size_t)32 * 32 * 32768;
      for (int i = F.bid * NTHR + F.tid; i < 32 * 1792; i += F.G * NTHR) { const int kt = i / 1792, j = i - kt * 1792; *(GAS v4u*)(tb + (size_t)kt * 32768 + 32 * 128 + (size_t)j * 16) = (v4u){0u, 0u, 0u, 0u}; } }
    { float* rope = (float*)(ws + WS_ROPE);
      for (int i = F.bid * NTHR + F.tid; i < 8196 * 8; i += F.G * NTHR) {
          const int pos = i >> 3, k = i & 7;
          const double invf = k == 0 ? 1.0 : k == 1 ? 0.193922758102417 : k == 2 ? 0.03760603442788124 : k == 3 ? 0.007292666472494602 : k == 4 ? 0.0014142136787995696 : k == 5 ? 0.00027424818836152554 : k == 6 ? 5.318298644851893e-05 : 1.031338433676865e-05;
          const float angf = (float)pos * (float)invf;
          const double rev = (double)angf * 0.15915494309189535;
          const float fr = (float)(rev - __builtin_rint(rev));
          rope[pos * 16 + k] = __builtin_amdgcn_cosf(fr); rope[pos * 16 + 8 + k] = __builtin_amdgcn_sinf(fr);
      } }
    { const GAS f32x4* src = (const GAS f32x4*)F.in[1]; GAS f32x4* dst = (GAS f32x4*)((float*)(ws + WS_H) + (size_t)MP * DM);
      for (int i = F.bid * NTHR + F.tid; i < MS * DM / 4; i += F.G * NTHR) dst[i] = src[i]; }
    norm_phase(F, F.in[0], (float*)F.in[1], F.in[8], (bf16*)(ws + WS_XN), false);
}

constexpr int AT_KSTR = 144;
constexpr int AT_K = 0, AT_V = 256 * AT_KSTR;
template <bool SINK, bool OBLK>
DI void attn_prompt_unit(Frame& F, const bf16* QKV, int ld, int qcol0, int kcol, int vcol, int dil, int rho, int cb, int maxd,
                         const float* sink4, bf16* O, int ldo, int ocol0, float* lse, int hq0) {
    LAS unsigned char* lds = F.lds;
    const int tid = F.tid, lane = F.lane, wave = F.wave, r = lane & 31, h = lane >> 5;
    __syncthreads();
#pragma unroll
    for (int i = 0; i < 4; ++i) {
        const int c = tid + NTHR * i, row = c >> 3, ch = c & 7;
        const int mk = 128 * (cb - 1) + row;
        v4u kv = (v4u){0u, 0u, 0u, 0u}, vv = (v4u){0u, 0u, 0u, 0u};
        if (mk >= 0) { const size_t t = (size_t)mk * dil + rho; kv = *(const GAS v4u*)(QKV + t * ld + kcol + 8 * ch); vv = *(const GAS v4u*)(QKV + t * ld + vcol + 8 * ch); }
        *(LAS v4u*)(lds + AT_K + row * AT_KSTR + ch * 16) = kv;
        *(LAS v4u*)(lds + AT_V + (ch >> 2) * 16384 + row * 64 + (ch & 3) * 16) = vv;
    }
    __syncthreads();
    const int g4 = (lane >> 4) & 1, q4 = (lane & 15) >> 2, p4 = lane & 3;
#pragma unroll 1
    for (int jb = wave; jb < 16; jb += 8) {
        const int qt = jb & 3, rep = jb >> 2;
        const int mq = 128 * cb + 32 * qt + r; const size_t tq = (size_t)mq * dil + rho;
        bf16x8 qf[4];
        { const bf16* qp = QKV + tq * ld + qcol0 + rep * 64 + 8 * h;
#pragma unroll
          for (int ks = 0; ks < 4; ++ks) qf[ks] = *(const GAS bf16x8*)(qp + 16 * ks); }
        f32x16 X[5];
#pragma unroll
        for (int kt = 0; kt < 5; ++kt) {
#pragma unroll
            for (int e = 0; e < 16; ++e) X[kt][e] = 0.f;
#pragma unroll
            for (int ks = 0; ks < 4; ++ks) {
                const bf16x8 kf = *(const LAS bf16x8*)(lds + AT_K + (32 * qt + 32 * kt + r) * AT_KSTR + (16 * ks + 8 * h) * 2);
                X[kt] = MFMA32(kf, qf[ks], X[kt]);
            }
            __builtin_amdgcn_sched_barrier(0);
        }
        const float NEG = -3.0e38f;
        float mx = NEG;
#pragma unroll
        for (int kt = 0; kt < 5; ++kt)
#pragma unroll
            for (int e = 0; e < 16; ++e) {
                const int jw = 32 * kt + crow(e, h), dist = 128 + r - jw;
                const bool ok = (dist >= 0) && (dist <= maxd) && (cb > 0 || (32 * qt + jw) >= 128);
                X[kt][e] = ok ? X[kt][e] : NEG;
                mx = fmaxf(mx, X[kt][e]);
            }
        mx = fmaxf(mx, __shfl_xor(mx, 32));
        float msc = mx * 0.125f; float sk = 0.f;
        if (SINK) { sk = sink4[rep]; msc = fmaxf(msc, sk); }
        const float c1 = 0.125f * 1.4426950408889634f, c2 = msc * 1.4426950408889634f;
        float den = 0.f;
#pragma unroll
        for (int kt = 0; kt < 5; ++kt)
#pragma unroll
            for (int e = 0; e < 16; ++e) { const float p = fexp2(X[kt][e] * c1 - c2); X[kt][e] = p; den += p; }
        den += __shfl_xor(den, 32);
        if (SINK) den += fexp2((sk - msc) * 1.4426950408889634f);
        f32x16 Oa[2];
#pragma unroll
        for (int d = 0; d < 2; ++d)
#pragma unroll
            for (int e = 0; e < 16; ++e) Oa[d][e] = 0.f;
#pragma unroll
        for (int kt = 0; kt < 5; ++kt)
#pragma unroll
            for (int s = 0; s < 2; ++s) {
                const bf16x8 pf = pack8(X[kt][8 * s], X[kt][8 * s + 1], X[kt][8 * s + 2], X[kt][8 * s + 3], X[kt][8 * s + 4], X[kt][8 * s + 5], X[kt][8 * s + 6], X[kt][8 * s + 7]);
                const int krow0 = 32 * qt + 32 * kt + 16 * s + 4 * h + q4;
#pragma unroll
                for (int d = 0; d < 2; ++d) {
                    const LAS unsigned char* vp = lds + AT_V + d * 16384 + krow0 * 64 + 32 * g4 + 8 * p4;
                    const bf16x8 vf = cat8(trr(vp), trr(vp + 8 * 64));
                    Oa[d] = MFMA32(vf, pf, Oa[d]);
                }
                __builtin_amdgcn_sched_barrier(0);
            }
        const float inv = 1.0f / den;
        bf16* op = OBLK ? O + ablk((int)tq, ocol0 + rep * 64, ldo) : O + tq * ldo + ocol0 + rep * 64;
#pragma unroll
        for (int d = 0; d < 2; ++d)
#pragma unroll
            for (int rq = 0; rq < 4; ++rq) {
                v2u w; w.x = pk2(Oa[d][4 * rq] * inv, Oa[d][4 * rq + 1] * inv); w.y = pk2(Oa[d][4 * rq + 2] * inv, Oa[d][4 * rq + 3] * inv);
                *(GAS v2u*)(op + 32 * d + 8 * rq + 4 * h) = w;
            }
        if (lse != nullptr && h == 0) lse[tq * 32 + hq0 + rep] = msc + __logf(den);
    }
}

DI void attn_sample_swa_unit(Frame& F, int b, int g) {
    LAS float* Ks = (LAS float*)F.lds;
    LAS float* Vs = Ks + 132 * 65;
    LAS float* Qs = Vs + 132 * 64;
    LAS float* Ps = Qs + 16 * 64;
    const int tid = F.tid;
    const bf16* P1 = (const bf16*)(F.ws + WS_P1);
    const float* ck = F.in[4] + (size_t)b * 128 * 512 + g * 64; const float* cv = F.in[5] + (size_t)b * 128 * 512 + g * 64;
    __syncthreads();
    for (int i = tid; i < 132 * 64; i += NTHR) {
        const int j = i >> 6, d = i & 63; float kk, vv;
        if (j < 128) { kk = ck[(size_t)j * 512 + d]; vv = cv[(size_t)j * 512 + d]; }
        else { const size_t row = (size_t)(MP + 4 * b + (j - 128)) * N1; kk = bflo(P1[row + C_K + g * 64 + d]); vv = bflo(P1[row + C_V + g * 64 + d]); }
        Ks[j * 65 + d] = kk; Vs[j * 64 + d] = vv;
    }
    for (int i = tid; i < 16 * 64; i += NTHR) { const int qr = i >> 6, d = i & 63, rep = qr >> 2, t = qr & 3;
        Qs[i] = bflo(P1[(size_t)(MP + 4 * b + t) * N1 + C_Q + (4 * g + rep) * 64 + d]); }
    __syncthreads();
    const int qr = tid >> 5, ln = tid & 31, rep = qr >> 2, t = qr & 3;
    float sc[5]; float mx = -3.0e38f;
#pragma unroll
    for (int i = 0; i < 5; ++i) {
        const int j = ln + 32 * i; float s = -3.0e38f;
        if (j < 132) {
            const bool ok = j < 128 ? (j > t) : ((j - 128) <= t);
            if (ok) { float a = 0.f;
#pragma unroll 16
                for (int d = 0; d < 64; ++d) a += Qs[qr * 64 + d] * Ks[j * 65 + d];
                s = a * 0.125f; }
        }
        sc[i] = s; mx = fmaxf(mx, s);
    }
#pragma unroll
    for (int o = 1; o < 32; o <<= 1) mx = fmaxf(mx, __shfl_xor(mx, o));
    const float sk = F.in[17][4 * g + rep]; mx = fmaxf(mx, sk);
    float den = 0.f;
#pragma unroll
    for (int i = 0; i < 5; ++i) { const float p = sc[i] > -1.0e38f ? fexp(sc[i] - mx) : 0.f; sc[i] = p; den += p; }
#pragma unroll
    for (int o = 1; o < 32; o <<= 1) den += __shfl_xor(den, o);
    den += fexp(sk - mx);
    const float inv = 1.0f / den;
#pragma unroll
    for (int i = 0; i < 5; ++i) { const int j = ln + 32 * i; if (j < 132) Ps[qr * 136 + j] = sc[i] * inv; }
    __syncthreads();
    float o0 = 0.f, o1 = 0.f;
    for (int j = 0; j < 132; ++j) { const float p = Ps[qr * 136 + j]; o0 += p * Vs[j * 64 + 2 * ln]; o1 += p * Vs[j * 64 + 2 * ln + 1]; }
    bf16* MIX = (bf16*)(F.ws + WS_MIX);
    *(GAS unsigned*)(MIX + ablk(MP + 4 * b + t, 2048 + (4 * g + rep) * 64 + 2 * ln, KMIX)) = pk2(o0, o1);
}

constexpr int SD_ROWS = 516, SD_KSTR = 144, SD_K = 0, SD_V = SD_ROWS * SD_KSTR, SD_VH = SD_ROWS * 64, SD_OB = SD_V + 2 * SD_VH, SD_LB = SD_OB + 3 * 16 * 64 * 4;
DI void attn_sample_dil_unit(Frame& F, int b, int g) {
    LAS unsigned char* lds = F.lds;
    LAS float* Ob = (LAS float*)(lds + SD_OB);
    LAS float* Lb = (LAS float*)(lds + SD_LB);
    const int tid = F.tid, wave = F.wave, lane = F.lane, r = lane & 31, h = lane >> 5;
    const bf16* P5 = (const bf16*)(F.ws + WS_P5);
    const float* ck = F.in[6] + (size_t)b * 2048 * 512 + g * 64; const float* cv = F.in[7] + (size_t)b * 2048 * 512 + g * 64;
    const int g4 = (lane >> 4) & 1, q4 = (lane & 15) >> 2, p4 = lane & 3;
#pragma unroll 1
    for (int pass = 0; pass < 2; ++pass) {
        __syncthreads();
#pragma unroll
        for (int it = 0; it < 9; ++it) {
            const int item = tid + NTHR * it;
            if (item < SD_ROWS * 8) {
                const int row = item >> 3, ch = item & 7;
                int off;
                if (pass == 0) off = row - 512; else { const int t = row / 129, k = row - 129 * t; off = t - 16 * k; }
                v4u kq, vq;
                if (off < 0) {
                    const float* kp = ck + (size_t)(2048 + off) * 512 + 8 * ch; const float* vp = cv + (size_t)(2048 + off) * 512 + 8 * ch;
                    const f32x4 k0 = *(const GAS f32x4*)kp, k1 = *(const GAS f32x4*)(kp + 4), v0 = *(const GAS f32x4*)vp, v1 = *(const GAS f32x4*)(vp + 4);
                    kq.x = pk2(k0[0], k0[1]); kq.y = pk2(k0[2], k0[3]); kq.z = pk2(k1[0], k1[1]); kq.w = pk2(k1[2], k1[3]);
                    vq.x = pk2(v0[0], v0[1]); vq.y = pk2(v0[2], v0[3]); vq.z = pk2(v1[0], v1[1]); vq.w = pk2(v1[2], v1[3]);
                } else {
                    const bf16* rp = P5 + (size_t)(MP + 4 * b + off) * N5 + g * 64 + 8 * ch;
                    kq = *(const GAS v4u*)(rp + O_K); vq = *(const GAS v4u*)(rp + O_V);
                }
                *(LAS v4u*)(lds + SD_K + row * SD_KSTR + ch * 16) = kq;
                *(LAS v4u*)(lds + SD_V + (ch >> 2) * SD_VH + row * 64 + (ch & 3) * 16) = vq;
            }
        }
        __syncthreads();
        if (pass == 0 || wave < 4) {
            const int pat = pass == 0 ? (wave >> 2) : 2, t = wave & 3;
            auto rowof = [&](int k) -> int { k = k > 128 ? 128 : k; return pass == 0 ? (512 + t - (pat == 0 ? k : 4 * k)) : (129 * t + k); };
            bf16x8 qf[4];
            { const bf16* qp = P5 + (size_t)(MP + 4 * b + t) * N5 + pat * 2048 + (4 * g + (r & 3)) * 64 + 8 * h;
#pragma unroll
              for (int ks = 0; ks < 4; ++ks) qf[ks] = *(const GAS bf16x8*)(qp + 16 * ks); }
            f32x16 X[5];
#pragma unroll
            for (int kt = 0; kt < 5; ++kt) {
#pragma unroll
                for (int e = 0; e < 16; ++e) X[kt][e] = 0.f;
                const int krow = rowof(32 * kt + r);
#pragma unroll
                for (int ks = 0; ks < 4; ++ks) {
                    const bf16x8 kf = *(const LAS bf16x8*)(lds + SD_K + krow * SD_KSTR + (16 * ks + 8 * h) * 2);
                    X[kt] = MFMA32(kf, qf[ks], X[kt]);
                }
                __builtin_amdgcn_sched_barrier(0);
            }
            const float NEG = -3.0e38f;
            float mx = NEG;
#pragma unroll
            for (int kt = 0; kt < 5; ++kt)
#pragma unroll
                for (int e = 0; e < 16; ++e) { const bool ok = (32 * kt + crow(e, h)) <= 128; X[kt][e] = ok ? X[kt][e] : NEG; mx = fmaxf(mx, X[kt][e]); }
            mx = fmaxf(mx, __shfl_xor(mx, 32));
            const float msc = mx * 0.125f, c1 = 0.125f * 1.4426950408889634f, c2 = msc * 1.4426950408889634f;
            float den = 0.f;
#pragma unroll
            for (int kt = 0; kt < 5; ++kt)
#pragma unroll
                for (int e = 0; e < 16; ++e) { const float p = fexp2(X[kt][e] * c1 - c2); X[kt][e] = p; den += p; }
            den += __shfl_xor(den, 32);
            f32x16 Oa[2];
#pragma unroll
            for (int d = 0; d < 2; ++d)
#pragma unroll
                for (int e = 0; e < 16; ++e) Oa[d][e] = 0.f;
#pragma unroll
            for (int kt = 0; kt < 5; ++kt)
#pragma unroll
                for (int s2 = 0; s2 < 2; ++s2) {
                    const bf16x8 pf = pack8(X[kt][8 * s2], X[kt][8 * s2 + 1], X[kt][8 * s2 + 2], X[kt][8 * s2 + 3], X[kt][8 * s2 + 4], X[kt][8 * s2 + 5], X[kt][8 * s2 + 6], X[kt][8 * s2 + 7]);
                    const int k0 = 32 * kt + 16 * s2 + 4 * h + q4;
                    const int ra = rowof(k0), rb = rowof(k0 + 8);
#pragma unroll
                    for (int d = 0; d < 2; ++d) {
                        const LAS unsigned char* vb = lds + SD_V + d * SD_VH + 32 * g4 + 8 * p4;
                        const bf16x8 vf = cat8(trr(vb + ra * 64), trr(vb + rb * 64));
                        Oa[d] = MFMA32(vf, pf, Oa[d]);
                    }
                    __builtin_amdgcn_sched_barrier(0);
                }
            if (r < 4) {
                const float inv = 1.0f / den;
                LAS float* ob = Ob + ((pat * 4 + t) * 4 + r) * 64;
#pragma unroll
                for (int d = 0; d < 2; ++d)
#pragma unroll
                    for (int e = 0; e < 16; ++e) ob[32 * d + crow(e, h)] = Oa[d][e] * inv;
                if (h == 0) Lb[(pat * 4 + t) * 4 + r] = msc + __logf(den);
            }
        }
    }
    __syncthreads();
    bf16* MRG = (bf16*)(F.ws + WS_MRG);
    { const int i = tid * 2;
        const int d = i & 63, rep = (i >> 6) & 3, t = i >> 8;
        const float l0 = Lb[(0 * 4 + t) * 4 + rep], l1 = Lb[(1 * 4 + t) * 4 + rep], l2 = Lb[(2 * 4 + t) * 4 + rep];
        const float lm = fmaxf(l0, fmaxf(l1, l2)); float w0 = fexp(l0 - lm), w1 = fexp(l1 - lm), w2 = fexp(l2 - lm);
        const float inv = 1.0f / (w0 + w1 + w2); w0 *= inv; w1 *= inv; w2 *= inv;
        const LAS float* o0 = Ob + ((0 * 4 + t) * 4 + rep) * 64 + d; const LAS float* o1 = Ob + ((1 * 4 + t) * 4 + rep) * 64 + d; const LAS float* o2 = Ob + ((2 * 4 + t) * 4 + rep) * 64 + d;
        *(GAS unsigned*)(MRG + ablk(MP + 4 * b + t, (4 * g + rep) * 64 + d, DM)) = pk2(w0 * o0[0] + w1 * o1[0] + w2 * o2[0], w0 * o0[1] + w1 * o1[1] + w2 * o2[1]);
    }
}

DI void ssd_dt_scan(Frame& F, int t0, int head, float& dt0, float& dt1, float& acs0, float& acs1, float& total) {
    const float* DT = (const float*)(F.ws + WS_DT);
    const float bias = F.in[13][head], a = -__expf(F.in[14][head]);
    const int l = 2 * F.lane;
    dt0 = softplusf_(DT[(size_t)(t0 + l) * 32 + head] + bias); dt1 = softplusf_(DT[(size_t)(t0 + l + 1) * 32 + head] + bias);
    const float la0 = dt0 * a, la1 = dt1 * a;
    float s = la0 + la1;
#pragma unroll
    for (int o = 1; o < 64; o <<= 1) { const float v = __shfl_up(s, o); if (F.lane >= o) s += v; }
    acs1 = s; acs0 = s - la1; total = __shfl(s, 63);
}

template <class Sink>
DI void conv_task(Frame& F, int t0, int l0, int chabs, const Sink& sink) {
    const bf16* P1 = (const bf16*)(F.ws + WS_P1);
    const float* cw = F.in[11]; const float* cbias = F.in[12];
    float w[4][8], bs[8];
#pragma unroll
    for (int i = 0; i < 4; ++i) { const f32x4 a = *(const f32x4*)(cw + i * CONVD + chabs), b = *(const f32x4*)(cw + i * CONVD + chabs + 4);
        w[i][0] = a[0]; w[i][1] = a[1]; w[i][2] = a[2]; w[i][3] = a[3]; w[i][4] = b[0]; w[i][5] = b[1]; w[i][6] = b[2]; w[i][7] = b[3]; }
    { const f32x4 a = *(const f32x4*)(cbias + chabs), b = *(const f32x4*)(cbias + chabs + 4); bs[0] = a[0]; bs[1] = a[1]; bs[2] = a[2]; bs[3] = a[3]; bs[4] = b[0]; bs[5] = b[1]; bs[6] = b[2]; bs[7] = b[3]; }
    float hst[3][8];
#pragma unroll
    for (int i = 0; i < 3; ++i) {
        const int t = t0 + l0 - 3 + i; v4u u = (v4u){0u, 0u, 0u, 0u};
        if (t >= 0) u = *(const GAS v4u*)(P1 + (size_t)t * N1 + C_XBC + chabs);
        hst[i][0] = bflo(u.x); hst[i][1] = bfhi(u.x); hst[i][2] = bflo(u.y); hst[i][3] = bfhi(u.y); hst[i][4] = bflo(u.z); hst[i][5] = bfhi(u.z); hst[i][6] = bflo(u.w); hst[i][7] = bfhi(u.w);
    }
#pragma unroll
    for (int i = 0; i < 16; ++i) {
        const v4u u = *(const GAS v4u*)(P1 + (size_t)(t0 + l0 + i) * N1 + C_XBC + chabs);
        float cur[8] = {bflo(u.x), bfhi(u.x), bflo(u.y), bfhi(u.y), bflo(u.z), bfhi(u.z), bflo(u.w), bfhi(u.w)};
        float o[8];
#pragma unroll
        for (int j = 0; j < 8; ++j) { const float a = bs[j] + w[0][j] * hst[0][j] + w[1][j] * hst[1][j] + w[2][j] * hst[2][j] + w[3][j] * cur[j]; o[j] = siluf_(a);
            hst[0][j] = hst[1][j]; hst[1][j] = hst[2][j]; hst[2][j] = cur[j]; }
        sink(l0 + i, o);
    }
}

constexpr int SA_W = 0, SA_B = 8192, SA_BSTR = 320, SA_X = SA_B + 128 * SA_BSTR, SA_XSTR = 576;
DI void ssd_a_unit(Frame& F, int c, int g) {
    LAS unsigned char* lds = F.lds;
    LAS float* Wl = (LAS float*)(lds + SA_W);
    const int tid = F.tid, lane = F.lane, wave = F.wave, r = lane & 31, h = lane >> 5, t0 = 128 * c;
    bf16* XC = (bf16*)(F.ws + WS_XC); float* ST = (float*)(F.ws + WS_ST); float* CD = (float*)(F.ws + WS_CD);
    __syncthreads();
    { float dt0, dt1, a0, a1, tot; ssd_dt_scan(F, t0, 8 * g + wave, dt0, dt1, a0, a1, tot);
      Wl[wave * 128 + 2 * lane] = dt0 * __expf(tot - a0); Wl[wave * 128 + 2 * lane + 1] = dt1 * __expf(tot - a1);
      if (lane == 63) CD[c * 32 + 8 * g + wave] = __expf(tot); }
    __syncthreads();
    const int g4 = (lane >> 4) & 1, q4 = (lane & 15) >> 2, p4 = lane & 3;
#pragma unroll 1
    for (int half = 0; half < 2; ++half) {
        if (half == 0 || tid < 256) {
            int oct, run; if (half == 0) { oct = tid & 63; run = tid >> 6; } else { oct = 32 + (tid & 31); run = tid >> 5; }
            int chabs, kind, lcol, hh = 0;
            if (oct < 16) { kind = 0; chabs = 2048 + 128 * g + 8 * oct; lcol = 8 * oct; }
            else if (oct < 32) { kind = 1; chabs = 2560 + 128 * g + 8 * (oct - 16); lcol = 0; }
            else { kind = 2; const int idx = oct - 32, hl = idx >> 3; hh = 4 * half + hl; chabs = 512 * g + 64 * hh + 8 * (idx & 7); lcol = 64 * hl + 8 * (idx & 7); }
            conv_task(F, t0, 16 * run, chabs, [&](int l, const float (&o)[8]) {
                v4u pkd; pkd.x = pk2(o[0], o[1]); pkd.y = pk2(o[2], o[3]); pkd.z = pk2(o[4], o[5]); pkd.w = pk2(o[6], o[7]);
                *(GAS v4u*)(XC + (size_t)(t0 + l) * CONVD + chabs) = pkd;
                if (kind == 0) *(LAS v4u*)(lds + SA_B + l * SA_BSTR + lcol * 2) = pkd;
                else if (kind == 2) { const float wv = Wl[hh * 128 + l]; v4u s; s.x = pk2(o[0] * wv, o[1] * wv); s.y = pk2(o[2] * wv, o[3] * wv); s.z = pk2(o[4] * wv, o[5] * wv); s.w = pk2(o[6] * wv, o[7] * wv);
                    *(LAS v4u*)(lds + SA_X + l * SA_XSTR + lcol * 2) = s; }
            });
        }
        __syncthreads();
        { const int hl = wave >> 1, pt = wave & 1, head = 8 * g + 4 * half + hl;
          f32x16 acc[4];
#pragma unroll
          for (int nt = 0; nt < 4; ++nt)
#pragma unroll
              for (int e = 0; e < 16; ++e) acc[nt][e] = 0.f;
#pragma unroll
          for (int ks = 0; ks < 8; ++ks) {
              const int lrow = 16 * ks + 8 * h + q4;
              const LAS unsigned char* ap = lds + SA_X + lrow * SA_XSTR + (64 * hl + 32 * pt + 16 * g4 + 4 * p4) * 2;
              const bf16x8 af = cat8(trr(ap), trr(ap + 4 * SA_XSTR));
#pragma unroll
              for (int nt = 0; nt < 4; ++nt) {
                  const LAS unsigned char* bp = lds + SA_B + lrow * SA_BSTR + (32 * nt + 16 * g4 + 4 * p4) * 2;
                  const bf16x8 bfr = cat8(trr(bp), trr(bp + 4 * SA_BSTR));
                  acc[nt] = MFMA32(af, bfr, acc[nt]);
              }
          }
          float* sp = ST + ((size_t)(c * 32 + head) * 64) * 128;
#pragma unroll
          for (int nt = 0; nt < 4; ++nt)
#pragma unroll
              for (int e = 0; e < 16; ++e) sp[(size_t)(32 * pt + crow(e, h)) * 128 + 32 * nt + r] = acc[nt][e];
        }
        __syncthreads();
    }
}

DI void ssd_carry_phase(Frame& F) {
    const float* ST = (const float*)(F.ws + WS_ST); const float* CD = (const float*)(F.ws + WS_CD); bf16* HIN = (bf16*)(F.ws + WS_HIN);
    for (int gt = F.bid * NTHR + F.tid; gt < 131072; gt += F.G * NTHR) {
        const int e = 2 * gt, head = e >> 13;
        f32x2 hs = {0.f, 0.f};
#pragma unroll 1
        for (int c0 = 0; c0 < 64; c0 += 16) {
            f32x2 s[16]; float dc[16];
#pragma unroll
            for (int i = 0; i < 16; ++i) { s[i] = *(const GAS f32x2*)(ST + (size_t)(c0 + i) * 262144 + e); dc[i] = CD[(c0 + i) * 32 + head]; }
#pragma unroll
            for (int i = 0; i < 16; ++i) { *(GAS unsigned*)(HIN + (size_t)(c0 + i) * 262144 + e) = pk2(hs.x, hs.y); hs = hs * dc[i] + s[i]; }
        }
        *(GAS f32x2*)(F.out + OUT_PSSM + e) = hs;
    }
}

constexpr int SC_ACS = 0, SC_DT = 4096, SC_B = 8192, SC_STR = 272, SC_C = SC_B + 128 * SC_STR, SC_X = SC_C + 128 * SC_STR, SC_XSTR = 192, SC_H = SC_X + 128 * SC_XSTR, SC_SSQ = SC_H + 64 * SC_STR;
DI void ssd_c_unit(Frame& F, int c, int g) {
    LAS unsigned char* lds = F.lds;
    LAS float* ACS = (LAS float*)(lds + SC_ACS); LAS float* DTV = (LAS float*)(lds + SC_DT); LAS float* SSQ = (LAS float*)(lds + SC_SSQ);
    const int tid = F.tid, lane = F.lane, wave = F.wave, r = lane & 31, h = lane >> 5, t0 = 128 * c;
    const bf16* XC = (const bf16*)(F.ws + WS_XC); const bf16* HIN = (const bf16*)(F.ws + WS_HIN); const bf16* P1 = (const bf16*)(F.ws + WS_P1); bf16* MIX = (bf16*)(F.ws + WS_MIX);
    __syncthreads();
    { float dt0, dt1, a0, a1, tot; ssd_dt_scan(F, t0, 8 * g + wave, dt0, dt1, a0, a1, tot);
      ACS[wave * 128 + 2 * lane] = a0; ACS[wave * 128 + 2 * lane + 1] = a1; DTV[wave * 128 + 2 * lane] = dt0; DTV[wave * 128 + 2 * lane + 1] = dt1; }
#pragma unroll
    for (int i = 0; i < 4; ++i) { const int cc = tid + NTHR * i, row = cc >> 4, ch = cc & 15;
        *(LAS v4u*)(lds + SC_B + row * SC_STR + ch * 16) = *(const GAS v4u*)(XC + (size_t)(t0 + row) * CONVD + 2048 + 128 * g + 8 * ch);
        *(LAS v4u*)(lds + SC_C + row * SC_STR + ch * 16) = *(const GAS v4u*)(XC + (size_t)(t0 + row) * CONVD + 2560 + 128 * g + 8 * ch); }
    __syncthreads();
    const int lt = wave >> 1, pt = wave & 1, l = 32 * lt + r;
    const int g4 = (lane >> 4) & 1, q4 = (lane & 15) >> 2, p4 = lane & 3;
    const LAS unsigned char* cfp = lds + SC_C + l * SC_STR + 16 * h;
    unsigned Xp[4][8];
#pragma unroll
    for (int st = 0; st < 4; ++st) {
#pragma unroll
        for (int e = 0; e < 8; ++e) Xp[st][e] = 0u;
        if (st <= lt) {
            f32x16 X;
#pragma unroll
            for (int e = 0; e < 16; ++e) X[e] = 0.f;
#pragma unroll
            for (int ks = 0; ks < 8; ++ks) { const bf16x8 bfr = *(const LAS bf16x8*)(lds + SC_B + (32 * st + r) * SC_STR + (16 * ks + 8 * h) * 2); const bf16x8 cf = *(const LAS bf16x8*)(cfp + 32 * ks); X = MFMA32(bfr, cf, X); }
#pragma unroll
            for (int e = 0; e < 8; ++e) Xp[st][e] = pk2(X[2 * e], X[2 * e + 1]);
        }
    }
    float ssq = 0.f;
    bf16* myrow = MIX + ablk(t0 + l, 512 * g, KMIX) + 32 * pt + 4 * h;
#pragma unroll 1
    for (int hh = 0; hh < 8; ++hh) {
        const int head = 8 * g + hh;
        __syncthreads();
#pragma unroll
        for (int i = 0; i < 2; ++i) { const int cc = tid + NTHR * i;
            { const int row = cc >> 3, ch = cc & 7; *(LAS v4u*)(lds + SC_X + row * SC_XSTR + ch * 16) = *(const GAS v4u*)(XC + (size_t)(t0 + row) * CONVD + 512 * g + 64 * hh + 8 * ch); }
            { const int row = cc >> 4, ch = cc & 15; *(LAS v4u*)(lds + SC_H + row * SC_STR + ch * 16) = *(const GAS v4u*)(HIN + ((size_t)(c * 32 + head) * 64 + row) * 128 + 8 * ch); } }
        __syncthreads();
        f32x16 acc;
#pragma unroll
        for (int e = 0; e < 16; ++e) acc[e] = 0.f;
#pragma unroll
        for (int ks = 0; ks < 8; ++ks) { const bf16x8 hf = *(const LAS bf16x8*)(lds + SC_H + (32 * pt + r) * SC_STR + (16 * ks + 8 * h) * 2); const bf16x8 cf = *(const LAS bf16x8*)(cfp + 32 * ks); acc = MFMA32(hf, cf, acc); }
        const float al = ACS[hh * 128 + l], el = __expf(al);
#pragma unroll
        for (int e = 0; e < 16; ++e) acc[e] *= el;
#pragma unroll
        for (int st = 0; st < 4; ++st) {
            if (st <= lt) {
#pragma unroll
                for (int ss = 0; ss < 2; ++ss) {
                    float mv[8];
#pragma unroll
                    for (int j = 0; j < 8; ++j) {
                        const int e = 8 * ss + j, sl = crow(e, h), s = 32 * st + sl;
                        const float cb = (e & 1) ? bfhi(Xp[st][e >> 1]) : bflo(Xp[st][e >> 1]);
                        const float dec = __expf(al - ACS[hh * 128 + s]) * DTV[hh * 128 + s];
                        mv[j] = (st < lt || sl <= r) ? cb * dec : 0.f;
                    }
                    const bf16x8 mf = pack8(mv[0], mv[1], mv[2], mv[3], mv[4], mv[5], mv[6], mv[7]);
                    const LAS unsigned char* xp = lds + SC_X + (32 * st + 16 * ss + 4 * h + q4) * SC_XSTR + (32 * pt + 16 * g4 + 4 * p4) * 2;
                    const bf16x8 xf = cat8(trr(xp), trr(xp + 8 * SC_XSTR));
                    acc = MFMA32(xf, mf, acc);
                }
            }
        }
        const float dsk = F.in[15][head];
#pragma unroll
        for (int rq = 0; rq < 4; ++rq) {
            const int p0 = 32 * pt + 8 * rq + 4 * h;
            const v2u xx = *(const LAS v2u*)(lds + SC_X + l * SC_XSTR + p0 * 2);
            const v2u zz = *(const GAS v2u*)(P1 + (size_t)(t0 + l) * N1 + C_Z + 512 * g + 64 * hh + p0);
            const float xv[4] = {bflo(xx.x), bfhi(xx.x), bflo(xx.y), bfhi(xx.y)}, zv[4] = {bflo(zz.x), bfhi(zz.x), bflo(zz.y), bfhi(zz.y)};
            float y[4];
#pragma unroll
            for (int e = 0; e < 4; ++e) { y[e] = (acc[4 * rq + e] + dsk * xv[e]) * siluf_(zv[e]); ssq += y[e] * y[e]; }
            v2u w; w.x = pk2(y[0], y[1]); w.y = pk2(y[2], y[3]);
            *(GAS v2u*)(myrow + (size_t)16384 * hh + 8 * rq) = w;
        }
    }
    ssq += __shfl_xor(ssq, 32);
    if (h == 0) SSQ[pt * 128 + l] = ssq;
    asm volatile("s_waitcnt vmcnt(0)" ::: "memory");
    __syncthreads();
    const float rstd = 1.0f / sqrtf((SSQ[l] + SSQ[128 + l]) * (1.f / 512.f) + EPS);
    const float* gn = F.in[16] + 512 * g + 32 * pt + 4 * h;
#pragma unroll 1
    for (int hh = 0; hh < 8; ++hh)
#pragma unroll
        for (int rq = 0; rq < 4; ++rq) {
            const f32x4 gg = *(const f32x4*)(gn + 64 * hh + 8 * rq);
            const v2u yy = __builtin_nontemporal_load((const GAS v2u*)(myrow + (size_t)16384 * hh + 8 * rq));
            v2u w; w.x = pk2(bflo(yy.x) * rstd * gg[0], bfhi(yy.x) * rstd * gg[1]); w.y = pk2(bflo(yy.y) * rstd * gg[2], bfhi(yy.y) * rstd * gg[3]);
            *(GAS v2u*)(myrow + (size_t)16384 * hh + 8 * rq) = w;
        }
}

DI void ssd_sample_unit(Frame& F, int b, int g) {
    LAS float* xc = (LAS float*)F.lds;
    LAS float* dtv = xc + 4 * 768;
    LAS float* dav = dtv + 32;
    LAS float* ys = dav + 32;
    LAS float* rs = ys + 4 * 512;
    const int tid = F.tid, lane = F.lane, wave = F.wave;
    const bf16* P1 = (const bf16*)(F.ws + WS_P1); const float* DT = (const float*)(F.ws + WS_DT); bf16* MIX = (bf16*)(F.ws + WS_MIX);
    const size_t row0 = (size_t)MP + 4 * b;
    __syncthreads();
    for (int ch = tid; ch < 768; ch += NTHR) {
        const int chabs = ch < 512 ? 512 * g + ch : (ch < 640 ? 2048 + 128 * g + (ch - 512) : 2560 + 128 * g + (ch - 640));
        float xp[7];
#pragma unroll
        for (int i = 0; i < 3; ++i) xp[i] = F.in[2][((size_t)b * 3 + i) * CONVD + chabs];
#pragma unroll
        for (int t = 0; t < 4; ++t) xp[3 + t] = bflo(P1[(row0 + t) * N1 + C_XBC + chabs]);
        const float w0 = F.in[11][chabs], w1 = F.in[11][CONVD + chabs], w2 = F.in[11][2 * CONVD + chabs], w3 = F.in[11][3 * CONVD + chabs], bb = F.in[12][chabs];
#pragma unroll
        for (int t = 0; t < 4; ++t) xc[t * 768 + ch] = siluf_(bb + w0 * xp[t] + w1 * xp[t + 1] + w2 * xp[t + 2] + w3 * xp[t + 3]);
    }
    if (tid < 32) { const int t = tid >> 3, hh = tid & 7, head = 8 * g + hh;
        const float dt = softplusf_(DT[(row0 + t) * 32 + head] + F.in[13][head]); dtv[tid] = dt; dav[tid] = __expf(dt * -__expf(F.in[14][head])); }
    __syncthreads();
    const int p = tid >> 3, ns = (tid & 7) * 16;
    const float* hbase = F.in[3] + (((size_t)b * 32 + 8 * g) * 64 + p) * 128 + ns;
    f32x4 hn[4];
#pragma unroll
    for (int i = 0; i < 4; ++i) hn[i] = *(const GAS f32x4*)(hbase + 4 * i);
#pragma unroll 1
    for (int hh = 0; hh < 8; ++hh) {
        const int head = 8 * g + hh;
        float hv[16];
#pragma unroll
        for (int i = 0; i < 4; ++i) { hv[4 * i] = hn[i][0]; hv[4 * i + 1] = hn[i][1]; hv[4 * i + 2] = hn[i][2]; hv[4 * i + 3] = hn[i][3]; }
        if (hh < 7) {
#pragma unroll
            for (int i = 0; i < 4; ++i) hn[i] = *(const GAS f32x4*)(hbase + (size_t)(hh + 1) * 8192 + 4 * i);
        }
        const float dsk = F.in[15][head];
#pragma unroll
        for (int t = 0; t < 4; ++t) {
            const float da = dav[t * 8 + hh], xv = xc[t * 768 + 64 * hh + p], coef = dtv[t * 8 + hh] * xv;
            float part = 0.f;
#pragma unroll
            for (int i = 0; i < 16; ++i) { hv[i] = hv[i] * da + coef * xc[t * 768 + 512 + ns + i]; part += hv[i] * xc[t * 768 + 640 + ns + i]; }
            part += __shfl_xor(part, 1); part += __shfl_xor(part, 2); part += __shfl_xor(part, 4);
            if ((tid & 7) == 0) { const float z = bflo(P1[(row0 + t) * N1 + C_Z + 512 * g + 64 * hh + p]); ys[t * 512 + 64 * hh + p] = (part + dsk * xv) * siluf_(z); }
        }
        float* op = F.out + OUT_SSSM + (((size_t)b * 32 + head) * 64 + p) * 128 + ns;
#pragma unroll
        for (int i = 0; i < 4; ++i) *(GAS f32x4*)(op + 4 * i) = (f32x4){hv[4 * i], hv[4 * i + 1], hv[4 * i + 2], hv[4 * i + 3]};
    }
    __syncthreads();
    if (wave < 4) { float s = 0.f;
#pragma unroll
        for (int i = 0; i < 8; ++i) { const float v = ys[wave * 512 + lane + 64 * i]; s += v * v; }
        s = wave_sum(s); if (lane == 0) rs[wave] = 1.0f / sqrtf(s * (1.f / 512.f) + EPS); }
    __syncthreads();
    for (int i = tid; i < 4 * 256; i += NTHR) { const int t = i >> 8, cp = (i & 255) * 2; const float rr = rs[t];
        *(GAS unsigned*)(MIX + ablk((int)row0 + t, 512 * g + cp, KMIX)) = pk2(ys[t * 512 + cp] * rr * F.in[16][512 * g + cp], ys[t * 512 + cp + 1] * rr * F.in[16][512 * g + cp + 1]); }
}

DI void merge_phase(Frame& F) {
    const bf16* O3 = (const bf16*)(F.ws + WS_O3); const float* LSE = (const float*)(F.ws + WS_LSE); bf16* MRG = (bf16*)(F.ws + WS_MRG);
    for (int i = F.bid * NTHR + F.tid; i < MP * 32 * 8; i += F.G * NTHR) {
        const int d8 = i & 7, hq = (i >> 3) & 31, t = i >> 8;
        const float l0 = LSE[(size_t)t * 32 + hq], l1 = LSE[(size_t)MROWS * 32 + (size_t)t * 32 + hq], l2 = LSE[(size_t)2 * MROWS * 32 + (size_t)t * 32 + hq];
        const float lm = fmaxf(l0, fmaxf(l1, l2)); float w0 = fexp(l0 - lm), w1 = fexp(l1 - lm), w2 = fexp(l2 - lm);
        const float inv = 1.0f / (w0 + w1 + w2); w0 *= inv; w1 *= inv; w2 *= inv;
        const size_t off = (size_t)t * DM + hq * 64 + d8 * 8;
        const v4u a = *(const GAS v4u*)(O3 + off), b = *(const GAS v4u*)(O3 + (size_t)MROWS * DM + off), c = *(const GAS v4u*)(O3 + (size_t)2 * MROWS * DM + off);
        v4u o;
        o.x = pk2(w0 * bflo(a.x) + w1 * bflo(b.x) + w2 * bflo(c.x), w0 * bfhi(a.x) + w1 * bfhi(b.x) + w2 * bfhi(c.x));
        o.y = pk2(w0 * bflo(a.y) + w1 * bflo(b.y) + w2 * bflo(c.y), w0 * bfhi(a.y) + w1 * bfhi(b.y) + w2 * bfhi(c.y));
        o.z = pk2(w0 * bflo(a.z) + w1 * bflo(b.z) + w2 * bflo(c.z), w0 * bfhi(a.z) + w1 * bfhi(b.z) + w2 * bfhi(c.z));
        o.w = pk2(w0 * bflo(a.w) + w1 * bflo(b.w) + w2 * bflo(c.w), w0 * bfhi(a.w) + w1 * bfhi(b.w) + w2 * bfhi(c.w));
        *(GAS v4u*)(MRG + ablk(t, hq * 64 + d8 * 8, DM)) = o;
    }
}

struct Args { const float* in[24]; float* out; unsigned char* ws; int ph_lo, ph_hi; };
__global__ void __launch_bounds__(NTHR, 2) mega_fwd(Args args) {
    extern __shared__ __attribute__((aligned(16))) unsigned char lds_raw[];
    Frame F;
    F.lds = (LAS unsigned char*)lds_raw;
    F.tid = threadIdx.x; F.lane = F.tid & 63; F.wave = __builtin_amdgcn_readfirstlane(F.tid >> 6);
    F.G = gridDim.x; F.bid = blockIdx.x;
    F.in = args.in;
    F.out = args.out; F.ws = args.ws;
    volatile LAS unsigned* MISC = (volatile LAS unsigned*)(F.lds + MISC_OFF);
    if (F.tid < 64) MISC[F.tid] = 0u;
    __syncthreads();
    gu32* ctl = (gu32*)(F.ws + WS_CTL);
#if MK_ONE_LAUNCH
    XcdBarrier bar = xcd_barrier_post((unsigned*)(ctl + CW_BAR), MISC + 8);
#define GRID_BAR() xcd_barrier(bar)
#else
#define GRID_BAR() do { } while (0)
#endif
    const int lo = args.ph_lo, hi = args.ph_hi;
#ifndef PH_MASK
#define PH_MASK 0x3ffff
#endif
#define IN(k) ((((PH_MASK) >> (k)) & 1) && lo <= (k) && (k) < hi)
#ifndef PROBE_DUP2
#define PROBE_DUP2 -1
#endif
#ifndef PROBE_DUP
#define PROBE_DUP -1
#endif
#define REPS(k) for (int rep_ = 0; rep_ < ((k) == PROBE_DUP ? 2 : 1); ++rep_)
#ifdef PROBE_DBLBAR
#define SEAM(k) do { if (IN(k) && IN((k) + 1)) { GRID_BAR(); GRID_BAR(); } } while (0)
#else
#define SEAM(k) do { if (IN(k) && IN((k) + 1)) GRID_BAR(); } while (0)
#endif
    unsigned char* ws = F.ws;
    bf16* XN = (bf16*)(ws + WS_XN); bf16* P1 = (bf16*)(ws + WS_P1); bf16* MIX = (bf16*)(ws + WS_MIX); float* H = (float*)(ws + WS_H); bf16* U = (bf16*)(ws + WS_U);
    bf16* P5 = (bf16*)(ws + WS_P5); bf16* O3 = (bf16*)(ws + WS_O3); bf16* MRG = (bf16*)(ws + WS_MRG); float* LSE = (float*)(ws + WS_LSE);
    const float* rope = (const float*)(ws + WS_ROPE);
    using pg8::Gemm; using pg8::StaticOrder;

    if (IN(0)) REPS(0) { p0_prologue(F); } SEAM(0);
    if (IN(1)) REPS(1) { Gemm g{XN, (const bf16*)(ws + WS_W1T), MROWS, N1, DM}; StaticOrder S; S.init(MROWS, N1, F.G, F.bid, DM);
        pg8::EpiProj1 E{P1, (float*)(ws + WS_DT), rope, F.out};
        pg8::gemm_phase<pg8::EpiProj1, StaticOrder, true, true>(F.lds, g, S, E); tail_convert(F, (MROWS / 256) * (N1 / 256), 1); }
    if (IN(1) && PROBE_DUP2 == 1) { Gemm g{XN, (const bf16*)(ws + WS_W1T), MROWS, N1, DM}; StaticOrder S; S.init(MROWS, N1, F.G, F.bid, DM);
        pg8::EpiProj1 E{P1, (float*)(ws + WS_DT), rope, F.out};
        pg8::gemm_phase<pg8::EpiProj1, StaticOrder, true, true>(F.lds, g, S, E); tail_convert(F, (MROWS / 256) * (N1 / 256), 1); } SEAM(1);
    if (IN(2)) REPS(2) {
        REPS(20) for (int u = F.bid; u < 256; u += F.G) ssd_a_unit(F, u >> 2, u & 3);
        REPS(21) for (int u = F.bid; u < 512; u += F.G) { const int qb = u >> 3, g = u & 7;
            attn_prompt_unit<true, true>(F, P1, N1, C_Q + g * 256, C_K + g * 64, C_V + g * 64, 1, 0, qb, 127, F.in[17] + 4 * g, MIX, KMIX, 2048 + g * 256, nullptr, 0); }
        REPS(22) for (int u = F.bid; u < 512; u += F.G) ssd_sample_unit(F, u >> 2, u & 3);
        REPS(23) for (int u = F.bid; u < 1024; u += F.G) attn_sample_swa_unit(F, u >> 3, u & 7);
    } SEAM(2);
    if (IN(3)) REPS(3) { ssd_carry_phase(F); } SEAM(3);
    if (IN(4)) REPS(4) { for (int u = F.bid; u < 256; u += F.G) ssd_c_unit(F, u >> 2, u & 3); } SEAM(4);
    if (IN(5)) REPS(5) { __syncthreads(); Gemm g{MIX, (const bf16*)(ws + WS_W2T), MROWS, DM, KMIX}; pg8::SplitOrder S; S.init(F.G, F.bid, KMIX);
        pg8::EpiRes E{F.in[0], H, (float*)(ws + WS_PART)};
        pg8::gemm_phase<pg8::EpiRes, pg8::SplitOrder, true, true>(F.lds, g, S, E); } SEAM(5);
    if (IN(6)) REPS(6) { norm_phase(F, H, H + (size_t)MP * DM, F.in[9], XN, rep_ == 0); } SEAM(6);
    if (IN(7)) REPS(7) { Gemm g{XN, (const bf16*)(ws + WS_WM1T), MROWS, FF, DM}; StaticOrder S; S.init(MROWS, FF, F.G, F.bid, DM);
        pg8::EpiSq E{U};
        pg8::gemm_phase<pg8::EpiSq, StaticOrder, true, true>(F.lds, g, S, E); tail_convert(F, (MROWS / 256) * (FF / 256), 2); }
    if (IN(7) && PROBE_DUP2 == 7) { Gemm g{XN, (const bf16*)(ws + WS_WM1T), MROWS, FF, DM}; StaticOrder S; S.init(MROWS, FF, F.G, F.bid, DM);
        pg8::EpiSq E{U};
        pg8::gemm_phase<pg8::EpiSq, StaticOrder, true, true>(F.lds, g, S, E); tail_convert(F, (MROWS / 256) * (FF / 256), 2); } SEAM(7);
    if (IN(8)) REPS(8) { Gemm g{U, (const bf16*)(ws + WS_WM2T), MROWS, DM, FF}; pg8::SplitOrder S; S.init(F.G, F.bid, FF);
        pg8::EpiRes E{H, rep_ ? (float*)(ws + WS_O3) : H, (float*)(ws + WS_PART)};
        pg8::gemm_phase<pg8::EpiRes, pg8::SplitOrder, true, true>(F.lds, g, S, E); } SEAM(8);
    if (IN(9)) REPS(9) { norm_phase(F, H, H + (size_t)MP * DM, F.in[8] + DM, XN, rep_ == 0); } SEAM(9);
    if (IN(10)) REPS(10) { Gemm g{XN, (const bf16*)(ws + WS_W5T), MROWS, N5, DM}; StaticOrder S; S.init(MROWS, N5, F.G, F.bid, DM);
        pg8::EpiProj5 E{P5, rope, F.out, rep_};
        pg8::gemm_phase<pg8::EpiProj5, StaticOrder, true, true>(F.lds, g, S, E); tail_convert(F, (MROWS / 256) * (N5 / 256), 3); } SEAM(10);
    if (IN(11)) REPS(11) {
        REPS(110) for (int u = F.bid; u < 1536; u += F.G) { const int pat = u >> 9, v = u & 511, blk = v >> 3, g = v & 7;
            const int dil = pat == 0 ? 1 : (pat == 1 ? 4 : 16), nb = 64 / dil, rho = blk / nb, cb = blk % nb;
            attn_prompt_unit<false, false>(F, P5, N5, pat * 2048 + g * 256, O_K + g * 64, O_V + g * 64, dil, rho, cb, 128, nullptr, O3 + (size_t)pat * MROWS * DM, DM, g * 256, LSE + (size_t)pat * MROWS * 32, 4 * g); }
        REPS(111) for (int u = F.bid; u < 1024; u += F.G) attn_sample_dil_unit(F, u >> 3, u & 7);
    } SEAM(11);
    if (IN(12)) REPS(12) { merge_phase(F); } SEAM(12);
    if (IN(13)) REPS(13) { __syncthreads(); Gemm g{MRG, (const bf16*)(ws + WS_W6T), MROWS, DM, DM}; pg8::SplitOrder S; S.init(F.G, F.bid, DM);
        pg8::EpiRes E{H, rep_ ? (float*)(ws + WS_O3) : H, (float*)(ws + WS_PART)};
        pg8::gemm_phase<pg8::EpiRes, pg8::SplitOrder, true, true>(F.lds, g, S, E); } SEAM(13);
    if (IN(14)) REPS(14) { norm_phase(F, H, H + (size_t)MP * DM, F.in[9] + DM, XN, rep_ == 0); } SEAM(14);
    if (IN(15)) REPS(15) { Gemm g{XN, (const bf16*)(ws + WS_WM1T) + (size_t)FF * DM, MROWS, FF, DM}; StaticOrder S; S.init(MROWS, FF, F.G, F.bid, DM);
        pg8::EpiSq E{U};
        pg8::gemm_phase<pg8::EpiSq, StaticOrder, true, true>(F.lds, g, S, E); tail_convert(F, (MROWS / 256) * (FF / 256), 4); } SEAM(15);
    if (IN(16)) REPS(16) { Gemm g{U, (const bf16*)(ws + WS_WM2T) + (size_t)FF * DM, MROWS, DM, FF}; pg8::SplitOrder S; S.init(F.G, F.bid, FF);
        pg8::EpiRes E{H, rep_ ? (float*)(ws + WS_O3) : H, (float*)(ws + WS_PART)};
        pg8::gemm_phase<pg8::EpiRes, pg8::SplitOrder, true, true>(F.lds, g, S, E); } SEAM(16);
    if (IN(17)) REPS(17) { const int gw = F.bid * NWAVES + F.wave, NGW = F.G * NWAVES;
        norm_sample_rows<true>(F, H + (size_t)MP * DM, F.in[23], nullptr, F.out + OUT_YS);
        f32x4 gg[8];
        { const GAS f32x4* gr = (const GAS f32x4*)F.in[23] + F.lane;
#pragma unroll
          for (int j = 0; j < 8; ++j) gg[j] = gr[64 * j]; }
        f32x4 cur[8], nxt[8];
        int m = gw;
        if (m < MP) rms_load_row(H + (size_t)m * DM, cur, F.lane);
        for (; m < MP; m += NGW) {
            if (m + NGW < MP) rms_load_row(H + (size_t)(m + NGW) * DM, nxt, F.lane);
            const float rs = rms_scale(cur);
            GAS f32x4* o = (GAS f32x4*)(F.out + (size_t)m * DM) + F.lane;
#pragma unroll
            for (int j = 0; j < 8; ++j) o[64 * j] = cur[j] * rs * gg[j];
#pragma unroll
            for (int j = 0; j < 8; ++j) cur[j] = nxt[j];
        } }
#undef IN
#undef SEAM
}

extern "C" void kernel_launch(void* const* d_in, const int* in_sizes, int n_in, void* d_out, int out_size, void* d_ws, size_t ws_size, hipStream_t stream) {
    static int grid = 0;
    if (grid == 0) {
        if (n_in != 24 || in_sizes[0] != MP * DM || (size_t)out_size != OUT_END || ws_size < WS_END) {
            fprintf(stderr, "kernel_launch: unexpected shapes: n_in %d in0 %d out %d (want %zu) ws %zu (want >= %zu)\n", n_in, n_in > 0 ? in_sizes[0] : -1, out_size, (size_t)OUT_END, ws_size, (size_t)WS_END); grid = -1; return; }
        int dev = 0, cus = 0, per_cu = 0;
        if (hipGetDevice(&dev) != hipSuccess || hipDeviceGetAttribute(&cus, hipDeviceAttributeMultiprocessorCount, dev) != hipSuccess) { fprintf(stderr, "kernel_launch: device query failed\n"); grid = -1; return; }
        if (hipFuncSetAttribute((const void*)mega_fwd, hipFuncAttributeMaxDynamicSharedMemorySize, LDS_BYTES) != hipSuccess) { fprintf(stderr, "kernel_launch: hipFuncSetAttribute failed\n"); grid = -1; return; }
        if (hipOccupancyMaxActiveBlocksPerMultiprocessor(&per_cu, (const void*)mega_fwd, NTHR, LDS_BYTES) != hipSuccess || per_cu < 1) { fprintf(stderr, "kernel_launch: occupancy query says %d blocks per CU\n", per_cu); }
        (void)hipGetLastError();
        grid = cus;
    }
    if (grid < 0) return;
    (void)hipMemsetAsync((char*)d_ws + WS_CTL, 0, CTL_ZERO_BYTES, stream);
    Args a{};
    for (int i = 0; i < 24; ++i) a.in[i] = (const float*)d_in[i];
    a.out = (float*)d_out; a.ws = (unsigned char*)d_ws;
#if MK_ONE_LAUNCH
    a.ph_lo = 0; a.ph_hi = NPH;
    hipLaunchKernelGGL(mega_fwd, dim3(grid), dim3(NTHR), LDS_BYTES, stream, a);
#ifdef PROBE_TWICE
    (void)hipMemsetAsync((char*)d_ws + WS_CTL, 0, CTL_ZERO_BYTES, stream);
    hipLaunchKernelGGL(mega_fwd, dim3(grid), dim3(NTHR), LDS_BYTES, stream, a);
#endif
#else
    for (int p = 0; p < NPH; ++p) { a.ph_lo = p; a.ph_hi = p + 1; hipLaunchKernelGGL(mega_fwd, dim3(grid), dim3(NTHR), LDS_BYTES, stream, a); }
#endif
    const hipError_t le = hipPeekAtLastError();
    if (le != hipSuccess) fprintf(stderr, "kernel_launch: launch failed: %s\n", hipGetErrorName(le));
}
```
